# Optimizing an MI355X kernel written in HIP

```python
import jax, jax.numpy as jnp
from jax import lax
import numpy as np

D_MODEL = 1024
BATCH = 16
SEQ = 2048
DEPTH = 1
DEC_BATCH = 128
DEC_SEQ = 8
PAST_LEN = 8192
PAGE_SIZE = 128

D_MIX = D_MODEL
D_A = D_MIX // 2
N_GROUPS_A = 4
GROUP_A = D_A // N_GROUPS_A
CHUNK = 128
D_B = D_MIX - D_A
N_HEADS_B = 8
HEAD_DIM = D_B // N_HEADS_B
PATTERNS = ((128, 1), (512, 4), (2048, 16))
WINDOW_MAX = 2048
BLK = 128
D_PLE = 256
EPS = 1e-6
NEG = -1e30
SCALE = HEAD_DIM ** -0.5
SPLITS = [D_A, 2 * D_A, 3 * D_A, 3 * D_A + D_B, 3 * D_A + 2 * D_B, 3 * D_A + 3 * D_B]
D_IN = 3 * D_A + 4 * D_B

kernel_name = "hymba_gmlp_dilated_attn_step"


def rms_norm(x, g):
    xf = x.astype(jnp.float32)
    y = xf * lax.rsqrt(jnp.mean(xf * xf, axis=-1, keepdims=True) + EPS)
    return (y * g.astype(jnp.float32)).astype(x.dtype)


def project(x, g_norm, w_in, g_q, g_k):
    B, S, _ = x.shape
    h = rms_norm(x, g_norm)
    proj = jnp.einsum('bsd,de->bse', h, w_in)
    u, va, za, q, k, vb, zb = jnp.split(proj, SPLITS, axis=-1)
    q = rms_norm(q.reshape(B, S, N_HEADS_B, HEAD_DIM), g_q)
    k = rms_norm(k.reshape(B, S, N_HEADS_B, HEAD_DIM), g_k)
    vb = vb.reshape(B, S, N_HEADS_B, HEAD_DIM)
    return u, va, za, q, k, vb, zb


def chunk_mlp(u, v, z, w_s, b_s, g_va, g_oa):
    B, L, _ = u.shape
    c = min(L, CHUNK)
    vn = rms_norm(v.reshape(B, L, N_GROUPS_A, GROUP_A), g_va)
    vc = vn.reshape(B, L // c, c, N_GROUPS_A, GROUP_A)
    ws = jnp.tril(w_s[:, :c, :c])
    mixed = jnp.einsum('gts,bnsgc->bntgc', ws, vc) + b_s[:, :c].T[None, None, :, :, None]
    a = u * mixed.reshape(B, L, D_A)
    a = rms_norm(a.reshape(B, L, N_GROUPS_A, GROUP_A), g_oa).reshape(B, L, D_A)
    return a * jax.nn.silu(z), vn.reshape(B, L, D_A)


def dilated_prompt_pattern(q, k, v, n, r):
    B, S, H, Dh = q.shape
    L = S // r
    nb = -(-L // BLK)
    Lp = nb * BLK

    def to_class(x):
        x = x.reshape(B, L, r, H, Dh).transpose(0, 2, 1, 3, 4)
        return jnp.pad(x, ((0, 0), (0, 0), (0, Lp - L), (0, 0), (0, 0)))

    def band(x):
        prev = jnp.pad(x, ((0, 0), (0, 0), (BLK, 0), (0, 0), (0, 0)))[:, :, :Lp]
        return jnp.concatenate([prev.reshape(B, r, nb, BLK, H, Dh),
                                x.reshape(B, r, nb, BLK, H, Dh)], axis=3)

    qb = to_class(q).reshape(B, r, nb, BLK, H, Dh).astype(jnp.float32)
    kb = band(to_class(k)).astype(jnp.float32)
    vb = band(to_class(v)).astype(jnp.float32)
    s = jnp.einsum('brnqhd,brnkhd->brnhqk', qb, kb) * SCALE
    qi = jnp.arange(BLK)[:, None]
    ki = jnp.arange(2 * BLK)[None, :]
    dist = BLK + qi - ki
    valid = ((dist >= 0) & (dist <= n))[None] & (
        (jnp.arange(nb)[:, None, None] > 0) | (ki >= BLK)[None])
    s = jnp.where(valid[None, None, :, None], s, NEG)
    m = jnp.max(s, axis=-1, keepdims=True)
    p = jnp.exp(s - m)
    den = jnp.sum(p, axis=-1, keepdims=True)
    o = jnp.einsum('brnhqk,brnkhd->brnhqd', p, vb) / den
    lse = (m + jnp.log(den))[..., 0]
    o = o.transpose(0, 1, 2, 4, 3, 5).reshape(B, r, Lp, H, Dh)[:, :, :L]
    o = o.transpose(0, 2, 1, 3, 4).reshape(B, S, H, Dh)
    lse = lse.transpose(0, 1, 2, 4, 3).reshape(B, r, Lp, H)[:, :, :L]
    lse = lse.transpose(0, 2, 1, 3).reshape(B, S, H)
    return o, lse


def dilated_sample_pattern(q, k_all, v_all, n, r):
    B, T, H, Dh = q.shape
    wb = k_all.shape[1] - T
    idx = wb + jnp.arange(T)[:, None] - r * jnp.arange(n + 1)[None, :]
    valid = idx >= 0
    idx = jnp.maximum(idx, 0)
    kg = jnp.take(k_all, idx, axis=1).astype(jnp.float32)
    vg = jnp.take(v_all, idx, axis=1).astype(jnp.float32)
    s = jnp.einsum('bthd,btkhd->bthk', q.astype(jnp.float32), kg) * SCALE
    s = jnp.where(valid[None, :, None, :], s, NEG)
    m = jnp.max(s, axis=-1, keepdims=True)
    p = jnp.exp(s - m)
    den = jnp.sum(p, axis=-1, keepdims=True)
    o = jnp.einsum('bthk,btkhd->bthd', p, vg) / den
    return o, (m + jnp.log(den))[..., 0]


def combine_by_denominator(outs, lses):
    w = jax.nn.softmax(jnp.stack(lses, axis=0), axis=0)
    return jnp.einsum('pbsh,pbshd->bshd', w, jnp.stack(outs, axis=0))


def finish(x, a_out, b_out, zb, g_ob, w_out, p, w_ple, g_ple, w_ple_gate):
    B, S, _ = x.shape
    b = rms_norm(b_out.astype(x.dtype), g_ob).reshape(B, S, D_B) * jax.nn.silu(zb)
    h = x + jnp.einsum('bse,ed->bsd', jnp.concatenate([a_out, b], axis=-1), w_out)
    gate = jax.nn.sigmoid(jnp.einsum('bsd,de->bse', h, w_ple_gate))
    e = rms_norm(jnp.einsum('bsp,pd->bsd', p, w_ple), g_ple)
    return h + gate * e


def setup_inputs(seed: int = 0) -> dict:
    key = jax.random.key(seed)
    ks = jax.random.split(key, 24)
    wb = min(WINDOW_MAX, PAST_LEN)
    f = jnp.float32

    def nrm(k, shape, scale=1.0):
        return jax.random.normal(k, shape, f) * scale

    def gain(k, shape):
        return 1.0 + 0.02 * jax.random.normal(k, shape, f)

    return {
        "x_prompt": nrm(ks[0], (BATCH, SEQ, D_MODEL)),
        "x_sample": nrm(ks[1], (DEC_BATCH, DEC_SEQ, D_MODEL)),
        "cache_k": nrm(ks[2], (DEPTH, DEC_BATCH, wb, N_HEADS_B, HEAD_DIM)),
        "cache_v": nrm(ks[3], (DEPTH, DEC_BATCH, wb, N_HEADS_B, HEAD_DIM)),
        "p_prompt": nrm(ks[4], (DEPTH, BATCH, SEQ, D_PLE)),
        "p_sample": nrm(ks[5], (DEPTH, DEC_BATCH, DEC_SEQ, D_PLE)),
        "g_norm": gain(ks[6], (DEPTH, D_MODEL)),
        "w_in": nrm(ks[7], (DEPTH, D_MODEL, D_IN), D_MODEL ** -0.5),
        "w_s": nrm(ks[8], (DEPTH, N_GROUPS_A, CHUNK, CHUNK), CHUNK ** -0.5),
        "b_s": 1.0 + 0.02 * nrm(ks[9], (DEPTH, N_GROUPS_A, CHUNK)),
        "g_va": gain(ks[10], (DEPTH, N_GROUPS_A, GROUP_A)),
        "g_oa": gain(ks[11], (DEPTH, N_GROUPS_A, GROUP_A)),
        "g_q": gain(ks[12], (DEPTH, HEAD_DIM)),
        "g_k": gain(ks[13], (DEPTH, HEAD_DIM)),
        "g_ob": gain(ks[14], (DEPTH, N_HEADS_B, HEAD_DIM)),
        "w_out": nrm(ks[15], (DEPTH, D_MIX, D_MODEL), D_MIX ** -0.5),
        "w_ple": nrm(ks[16], (DEPTH, D_PLE, D_MODEL), D_PLE ** -0.5),
        "g_ple": gain(ks[17], (DEPTH, D_MODEL)),
        "w_ple_gate": nrm(ks[18], (DEPTH, D_MODEL, D_MODEL), D_MODEL ** -0.5),
    }


def reference(x_prompt, x_sample, cache_k, cache_v, p_prompt, p_sample, g_norm, w_in, w_s,
              b_s, g_va, g_oa, g_q, g_k, g_ob, w_out, w_ple, g_ple, w_ple_gate):
    y_p, y_s = x_prompt, x_sample
    kp_list, vp_list, ks_list, vs_list, va_list = [], [], [], [], []
    for i in range(DEPTH):
        u, va, za, q, k, vb, zb = project(y_p, g_norm[i], w_in[i], g_q[i], g_k[i])
        a_out, _ = chunk_mlp(u, va, za, w_s[i], b_s[i], g_va[i], g_oa[i])
        outs, lses = [], []
        for (w, r) in PATTERNS:
            o, l = dilated_prompt_pattern(q, k, vb, w // r, r)
            outs.append(o)
            lses.append(l)
        b_out = combine_by_denominator(outs, lses)
        wb_p = min(WINDOW_MAX, y_p.shape[1])
        kp_list.append(k[:, -wb_p:])
        vp_list.append(vb[:, -wb_p:])
        y_p = finish(y_p, a_out, b_out, zb, g_ob[i], w_out[i], p_prompt[i], w_ple[i],
                     g_ple[i], w_ple_gate[i])

        u, va, za, q, k, vb, zb = project(y_s, g_norm[i], w_in[i], g_q[i], g_k[i])
        a_out, va_rows = chunk_mlp(u, va, za, w_s[i], b_s[i], g_va[i], g_oa[i])
        k_all = jnp.concatenate([cache_k[i].astype(k.dtype), k], axis=1)
        v_all = jnp.concatenate([cache_v[i].astype(vb.dtype), vb], axis=1)
        outs, lses = [], []
        for (w, r) in PATTERNS:
            o, l = dilated_sample_pattern(q, k_all, v_all, w // r, r)
            outs.append(o)
            lses.append(l)
        b_out = combine_by_denominator(outs, lses)
        ks_list.append(k)
        vs_list.append(vb)
        va_list.append(va_rows)
        y_s = finish(y_s, a_out, b_out, zb, g_ob[i], w_out[i], p_sample[i], w_ple[i],
                     g_ple[i], w_ple_gate[i])

    k_win_prompt = jnp.stack(kp_list, axis=0)
    v_win_prompt = jnp.stack(vp_list, axis=0)
    k_new_sample = jnp.stack(ks_list, axis=0)
    v_new_sample = jnp.stack(vs_list, axis=0)
    va_chunk_sample = jnp.stack(va_list, axis=0)
    return (y_p, y_s, k_win_prompt, v_win_prompt, k_new_sample, v_new_sample, va_chunk_sample)
```

```cpp
#include <hip/hip_runtime.h>
#include <cstdio>
#include <cstdint>
#ifndef MK_N_LAUNCHES
#define MK_N_LAUNCHES 1
#endif
namespace pg8 {
#define PG8_LAS __attribute__((address_space(3)))
typedef unsigned short bf16_t;
typedef short bf16x8 __attribute__((ext_vector_type(8)));
typedef float f32x4 __attribute__((ext_vector_type(4)));
typedef unsigned u32x4 __attribute__((ext_vector_type(4)));
constexpr int BM = 256, BK = 64, HALF = 128, HTB = HALF * BK * 2  , STAGE_BYTES = 8 * HTB, NXCD = 8, WGM = 8;

__host__ __device__ __forceinline__ int lds_byte(int r, int c) { const int st = (r >> 4) * 2 + (c >> 5), rr = r & 15, cc = c & 31, ob = rr * 64 + cc * 2; return st * 1024 + (ob ^ (((ob >> 9) & 1) << 5)); }
__host__ __device__ __forceinline__ void stage_rc(int b, int& R, int& C) { const int st = b / 1024, sb = b % 1024, swz = sb ^ (((sb >> 9) & 1) << 5); R = (st >> 1) * 16 + swz / 64; C = (st & 1) * 32 + (swz % 64) / 2; }
__host__ __device__ __forceinline__ int perm32(int rho) { const int n = rho >> 4, i = rho & 15; return 8 * (i >> 2) + 4 * n + (i & 3); }

struct Unit { int pm, pn; };
struct Gemm { const bf16_t* A; const bf16_t* Bt; int M, N, K; };

struct StaticOrder {
    int nM, nN, nwg, G, c;
    __host__ __device__ void init(int M, int N, int G_, int c_) { nM = M / BM; nN = N / BM; nwg = nM * nN; G = G_; c = c_; }
    __host__ __device__ bool next(int i, Unit& u) const {
        const long L = (long)i * G + c; if (L >= nwg) return false;
        int wgid = (int)L; { const int q = nwg / NXCD, r = nwg % NXCD, xcd = wgid % NXCD, off = wgid / NXCD; wgid = (xcd < r ? xcd * (q + 1) : r * (q + 1) + (xcd - r) * q) + off; }
        const int nig = WGM * nN, gid = wgid / nig, fm = gid * WGM, gsz = (nM - fm) < WGM ? (nM - fm) : WGM;
        u.pm = fm + ((wgid % nig) % gsz); u.pn = (wgid % nig) / gsz; return true;
    }
    __device__ __forceinline__ void a_ready(const Unit&) const {}
    __device__ __forceinline__ void done(const Unit&) const {}
};
template <class Epi, class Sched, bool ALIGN_EPI = false, bool SP2 = false>
__device__ __forceinline__ void gemm_phase(PG8_LAS unsigned char* lds, const Gemm g, const Sched& S, const Epi& E, const int wid  ) {
    const int lane = (int)__builtin_amdgcn_mbcnt_hi(~0u, __builtin_amdgcn_mbcnt_lo(~0u, 0u)), tid = wid * 64 + lane, wr = wid >> 2, wc = wid & 3, fr = lane & 15, fq = lane >> 4;
    const int K = g.K, nt = K / BK;
    unsigned voffA[2], voffB[2];
#pragma unroll
    for (int i = 0; i < 2; ++i) { int R, C; stage_rc(tid * 16 + i * 8192, R, C); const int Rb = Epi::PERM ? ((R & ~31) + perm32(R & 31)) : R;
        voffA[i] = (unsigned)(R * K + C) * 2u; voffB[i] = (unsigned)(Rb * K + C) * 2u; }
    const size_t kstep = (size_t)(BK * 2);
    const size_t hstep = (size_t)HALF * K * 2;
    const size_t tstep = 2 * hstep;
    const unsigned ldsw = (unsigned)wid * 1024u;
    const int aoff = lds_byte(wr * 64 + fr, fq * 8), boff = lds_byte(wc * 32 + fr, fq * 8);
#define PG8_SA(b, h) (((b) * 2 + (h)) * HTB)
#define PG8_SB(b, h) ((4 + (b) * 2 + (h)) * HTB)
#define PG8_STAGE(bufoff, gbase, voff) do { _Pragma("unroll") for (int _i = 0; _i < 2; ++_i) \
        __builtin_amdgcn_global_load_lds((const unsigned*)((const char*)(gbase) + (voff)[_i]), (PG8_LAS unsigned*)(lds + (bufoff) + ldsw + _i * 8192), 16, 0, 0); } while (0)
#define PG8_LDA(dst, b, h) do { _Pragma("unroll") for (int m = 0; m < 4; ++m) _Pragma("unroll") for (int k = 0; k < 2; ++k) dst[m][k] = *(const PG8_LAS bf16x8*)(lds + PG8_SA(b, h) + aoff + m * 2048 + k * 1024); } while (0)
#define PG8_LDB(dst, b, h) do { _Pragma("unroll") for (int n = 0; n < 2; ++n) _Pragma("unroll") for (int k = 0; k < 2; ++k) dst[n][k] = *(const PG8_LAS bf16x8*)(lds + PG8_SB(b, h) + boff + n * 2048 + k * 1024); } while (0)
#define PG8_MMA(ai, bj, At, Bt) do { __builtin_amdgcn_s_setprio(1); _Pragma("unroll") for (int m = 0; m < 4; ++m) _Pragma("unroll") for (int n = 0; n < 2; ++n) _Pragma("unroll") for (int k = 0; k < 2; ++k) \
        acc[ai][bj][m][n] = __builtin_amdgcn_mfma_f32_16x16x32_bf16(Bt[n][k], At[m][k], acc[ai][bj][m][n], 0, 0, 0); __builtin_amdgcn_s_setprio(0); } while (0)
#define PG8_WAIT_V(n) asm volatile("s_waitcnt vmcnt(" #n ")" ::: "memory")
#define PG8_WAIT_L(n) asm volatile("s_waitcnt lgkmcnt(" #n ")" ::: "memory")
#define PG8_BAR __builtin_amdgcn_s_barrier()
#define PG8_SCHED __builtin_amdgcn_sched_barrier(0)
    Unit cur, nxt; int ui = 0;
    if (!S.next(0, cur)) return;
    f32x4 acc[2][2][4][2];
#pragma unroll
    for (int a = 0; a < 2; ++a)
#pragma unroll
        for (int b = 0; b < 2; ++b)
#pragma unroll
            for (int m = 0; m < 4; ++m)
#pragma unroll
                for (int n = 0; n < 2; ++n) acc[a][b][m][n] = (f32x4){0.f, 0.f, 0.f, 0.f};
    bf16x8 At[4][2], B0[2][2], B1[2][2];
    const char* cA = (const char*)g.A + (size_t)cur.pm * tstep; const char* cB = (const char*)g.Bt + (size_t)cur.pn * tstep;
    S.a_ready(cur);
    if constexpr (SP2) {
        PG8_STAGE(PG8_SB(0, 0), cB, voffB); PG8_STAGE(PG8_SB(0, 1), cB + hstep, voffB); PG8_STAGE(PG8_SA(0, 0), cA, voffA); PG8_STAGE(PG8_SA(0, 1), cA + hstep, voffA);
        if (wr == 1) PG8_BAR;
        PG8_WAIT_V(2); PG8_BAR;
        PG8_STAGE(PG8_SB(1, 0), cB + kstep, voffB); PG8_STAGE(PG8_SA(1, 0), cA + kstep, voffA); PG8_STAGE(PG8_SB(1, 1), cB + hstep + kstep, voffB);
        PG8_WAIT_V(6); PG8_BAR;
    } else {
        PG8_STAGE(PG8_SB(0, 0), cB, voffB); PG8_STAGE(PG8_SA(0, 0), cA, voffA); PG8_STAGE(PG8_SB(0, 1), cB + hstep, voffB); PG8_STAGE(PG8_SA(0, 1), cA + hstep, voffA);
        if (wr == 1) PG8_BAR;
        PG8_WAIT_V(4); PG8_BAR;
        PG8_STAGE(PG8_SB(1, 0), cB + kstep, voffB); PG8_STAGE(PG8_SA(1, 0), cA + kstep, voffA); PG8_STAGE(PG8_SB(1, 1), cB + hstep + kstep, voffB);
        PG8_WAIT_V(6); PG8_BAR;
    }
    for (;;) {
        const bool has_next = S.next(ui + 1, nxt);
        const char* nA = has_next ? (const char*)g.A + (size_t)nxt.pm * tstep : cA; const char* nB = has_next ? (const char*)g.Bt + (size_t)nxt.pn * tstep : cB;
        for (int t = 0; t < nt; t += 2) {
            const bool last = (t == nt - 2);
            const char* a1 = cA + (size_t)(t + 1) * kstep;
            const char* a2 = last ? nA : cA + (size_t)(t + 2) * kstep; const char* b2 = last ? nB : cB + (size_t)(t + 2) * kstep;
            const char* a3 = a2 + kstep; const char* b3 = b2 + kstep;
            if (last && has_next) S.a_ready(nxt);
            if constexpr (SP2) {
            PG8_LDB(B0, 0, 0); PG8_LDB(B1, 0, 1); PG8_SCHED; PG8_LDA(At, 0, 0); PG8_STAGE(PG8_SA(1, 1), a1 + hstep, voffA);
            PG8_WAIT_V(8); PG8_WAIT_L(0); PG8_BAR; PG8_MMA(0, 0, At, B0); PG8_MMA(0, 1, At, B1); PG8_BAR; PG8_SCHED;
            PG8_LDA(At, 0, 1); PG8_STAGE(PG8_SB(0, 0), b2, voffB); PG8_STAGE(PG8_SB(0, 1), b2 + hstep, voffB); PG8_STAGE(PG8_SA(0, 0), a2, voffA);
            PG8_WAIT_V(8); PG8_WAIT_L(0); PG8_BAR; PG8_MMA(1, 0, At, B0); PG8_MMA(1, 1, At, B1); PG8_BAR; PG8_SCHED;
            PG8_LDB(B0, 1, 0); PG8_LDB(B1, 1, 1); PG8_SCHED; PG8_LDA(At, 1, 0); PG8_STAGE(PG8_SA(0, 1), a2 + hstep, voffA);
            PG8_WAIT_V(8); PG8_WAIT_L(0); PG8_BAR; PG8_MMA(0, 0, At, B0); PG8_MMA(0, 1, At, B1); PG8_BAR; PG8_SCHED;
            PG8_LDA(At, 1, 1); PG8_STAGE(PG8_SB(1, 0), b3, voffB); PG8_STAGE(PG8_SB(1, 1), b3 + hstep, voffB); PG8_STAGE(PG8_SA(1, 0), a3, voffA);
            PG8_WAIT_V(8); PG8_WAIT_L(0); PG8_BAR; PG8_MMA(1, 0, At, B0); PG8_MMA(1, 1, At, B1); PG8_BAR; PG8_SCHED;
            } else {
            PG8_LDB(B0, 0, 0); PG8_SCHED; PG8_LDA(At, 0, 0); PG8_STAGE(PG8_SA(1, 1), a1 + hstep, voffA);
            PG8_WAIT_L(8); PG8_BAR; PG8_WAIT_L(0); PG8_MMA(0, 0, At, B0); PG8_BAR; PG8_SCHED;
            PG8_LDB(B1, 0, 1); PG8_STAGE(PG8_SB(0, 0), b2, voffB);
            PG8_BAR; PG8_WAIT_L(0); PG8_MMA(0, 1, At, B1); PG8_BAR;
            PG8_LDA(At, 0, 1); PG8_STAGE(PG8_SA(0, 0), a2, voffA);
            PG8_BAR; PG8_WAIT_L(0); PG8_MMA(1, 0, At, B0); PG8_BAR; PG8_SCHED;
            PG8_STAGE(PG8_SB(0, 1), b2 + hstep, voffB);
            PG8_WAIT_V(6); PG8_BAR; PG8_MMA(1, 1, At, B1); PG8_BAR;
            PG8_LDB(B0, 1, 0); PG8_SCHED; PG8_LDA(At, 1, 0); PG8_STAGE(PG8_SA(0, 1), a2 + hstep, voffA);
            PG8_WAIT_L(8); PG8_BAR; PG8_WAIT_L(0); PG8_MMA(0, 0, At, B0); PG8_BAR; PG8_SCHED;
            PG8_LDB(B1, 1, 1); PG8_STAGE(PG8_SB(1, 0), b3, voffB);
            PG8_BAR; PG8_WAIT_L(0); PG8_MMA(0, 1, At, B1); PG8_BAR;
            PG8_LDA(At, 1, 1); PG8_STAGE(PG8_SA(1, 0), a3, voffA);
            PG8_BAR; PG8_WAIT_L(0); PG8_MMA(1, 0, At, B0); PG8_BAR; PG8_SCHED;
            PG8_STAGE(PG8_SB(1, 1), b3 + hstep, voffB);
            PG8_WAIT_V(6); PG8_BAR; PG8_MMA(1, 1, At, B1); PG8_BAR;
            }
        }
        if constexpr (ALIGN_EPI) { if (wr == 0) PG8_BAR; }
        if constexpr (!Epi::AFTER_DRAIN) { E(acc, cur, wr, wc, fr, fq); S.done(cur); }
        if (!has_next) break;
#pragma unroll
        for (int a = 0; a < 2; ++a)
#pragma unroll
            for (int b = 0; b < 2; ++b)
#pragma unroll
                for (int m = 0; m < 4; ++m)
#pragma unroll
                    for (int n = 0; n < 2; ++n) acc[a][b][m][n] = (f32x4){0.f, 0.f, 0.f, 0.f};
        cur = nxt; cA = nA; cB = nB; ++ui;
        if constexpr (ALIGN_EPI) { if (wr == 1) PG8_BAR; }
    }
    PG8_WAIT_V(0);
    if constexpr (!ALIGN_EPI) { if (wr == 0) PG8_BAR; }
    PG8_BAR;
    if constexpr (Epi::AFTER_DRAIN) { E.fused(acc, cur, wr, wc, fr, fq, lds, wid, lane); S.done(cur); }
#undef PG8_SA
#undef PG8_SB
#undef PG8_STAGE
#undef PG8_LDA
#undef PG8_LDB
#undef PG8_MMA
#undef PG8_WAIT_V
#undef PG8_WAIT_L
#undef PG8_BAR
#undef PG8_SCHED
}
}
namespace pg8 {
typedef float f32x2_t __attribute__((ext_vector_type(2)));
typedef __bf16 bf16x2_t __attribute__((ext_vector_type(2)));
typedef unsigned u32x2 __attribute__((ext_vector_type(2)));
__device__ __forceinline__ unsigned pk2(float lo, float hi) { f32x2_t v = {lo, hi}; bf16x2_t b = __builtin_convertvector(v, bf16x2_t); return __builtin_bit_cast(unsigned, b); }
__device__ __forceinline__ float bflo(unsigned u) { return __uint_as_float(u << 16); }
__device__ __forceinline__ float bfhi(unsigned u) { return __uint_as_float(u & 0xffff0000u); }
__device__ __forceinline__ float fast_sigmoid(float v) { return __builtin_amdgcn_rcpf(1.0f + __builtin_amdgcn_exp2f(-1.4426950408889634f * v)); }
constexpr float RMS_EPS = 1e-6f;
constexpr float QSCALE = 0.125f * 1.4426950408889634f;

constexpr int STG_OFF = 131072, STG_WAVE = 16 * 144;
template <bool NT = true> __device__ __forceinline__ void stage_store_128(PG8_LAS unsigned char* sw, int fr, int lane, int o0, const u32x4 v0, int o1, const u32x4 v1, unsigned char* g0, size_t pitch) {
    *(PG8_LAS u32x4*)(sw + fr * 144 + o0) = v0; *(PG8_LAS u32x4*)(sw + fr * 144 + o1) = v1;
#pragma unroll
    for (int i = 0; i < 2; ++i) { const int row = 8 * i + (lane >> 3), ch = lane & 7; const u32x4 t = *(const PG8_LAS u32x4*)(sw + row * 144 + 16 * ch); if (NT) __builtin_nontemporal_store(t, (u32x4*)(g0 + (size_t)row * pitch + 16 * ch)); else *(u32x4*)(g0 + (size_t)row * pitch + 16 * ch) = t; }
}
struct EpiInProj {
    static constexpr bool PERM = true, AFTER_DRAIN = false;
    const float* rstd; bf16_t* seg0; size_t seg_stride; float *kwin, *vwin, *knew, *vnew; const float *gq, *gk; int mp; PG8_LAS unsigned char* stg;
    __device__ __forceinline__ void operator()(const f32x4 (&acc)[2][2][4][2], const Unit& u, int wr, int wc, int fr, int fq) const {
        asm volatile("" : "+v"(fr), "+v"(fq));
        const int sg = u.pn >> 1;
        const int col0 = (u.pn & 1) * 256 + wc * 64 + 8 * fq;
        const int row0 = u.pm * BM + wr * 64 + fr;
        bf16_t* ob = seg0 + (size_t)sg * seg_stride;
        const bool prompt = row0 < mp;
        float* fo = nullptr;
        if (sg == 4) fo = prompt ? kwin : knew;
        if (sg == 5) fo = prompt ? vwin : vnew;
        const int frow0 = prompt ? row0 : row0 - mp;
        const bool do_norm = (sg == 3) || (sg == 4), do_silu = (sg == 2) || (sg == 6);
        f32x4 gn[2][2];
#pragma unroll
        for (int bj = 0; bj < 2; ++bj)
#pragma unroll
            for (int n = 0; n < 2; ++n) gn[bj][n] = (f32x4){1.f, 1.f, 1.f, 1.f};
        if (do_norm) { const float* g = (sg == 3) ? gq : gk; const float sc = (sg == 3) ? QSCALE : 1.0f;
#pragma unroll
            for (int bj = 0; bj < 2; ++bj)
#pragma unroll
                for (int n = 0; n < 2; ++n) gn[bj][n] = *(const f32x4*)(g + 32 * bj + 8 * fq + 4 * n) * sc; }
        float rsv[2][4];
#pragma unroll
        for (int m = 0; m < 4; ++m) rsv[0][m] = rstd[row0 + m * 16];
#pragma unroll
        for (int ai = 0; ai < 2; ++ai) {
#pragma unroll
            for (int m = 0; m < 4; ++m) {
                if (ai == 0 && m == 1) {
#pragma unroll
                    for (int mm = 0; mm < 4; ++mm) rsv[1][mm] = rstd[row0 + HALF + mm * 16];
                }
                const int r = row0 + ai * HALF + m * 16;
                const float rs = rsv[ai][m];
                f32x4 v[2][2];
#pragma unroll
                for (int bj = 0; bj < 2; ++bj)
#pragma unroll
                    for (int n = 0; n < 2; ++n) v[bj][n] = acc[ai][bj][m][n] * rs;
                if (do_norm) {
                    float ss = 0.f;
#pragma unroll
                    for (int bj = 0; bj < 2; ++bj)
#pragma unroll
                        for (int n = 0; n < 2; ++n) { const f32x4 x = v[bj][n]; ss += (x[0] * x[0] + x[1] * x[1]) + (x[2] * x[2] + x[3] * x[3]); }
                    ss += __shfl_xor(ss, 16); ss += __shfl_xor(ss, 32);
                    const float rn = 1.0f / sqrtf(ss * (1.0f / 64.0f) + RMS_EPS);
#pragma unroll
                    for (int bj = 0; bj < 2; ++bj)
#pragma unroll
                        for (int n = 0; n < 2; ++n) v[bj][n] = v[bj][n] * rn * gn[bj][n];
                }
                if (do_silu) {
#pragma unroll
                    for (int bj = 0; bj < 2; ++bj)
#pragma unroll
                        for (int n = 0; n < 2; ++n)
#pragma unroll
                            for (int j = 0; j < 4; ++j) v[bj][n][j] = v[bj][n][j] * fast_sigmoid(v[bj][n][j]);
                }
                const int lane_ = fr + 16 * fq; PG8_LAS unsigned char* sw = stg + (wr * 4 + wc) * STG_WAVE;
                const int rb = u.pm * BM + wr * 64 + ai * HALF + m * 16, cb = (u.pn & 1) * 256 + wc * 64;
                { u32x4 w0, w1; w0.x = pk2(v[0][0][0], v[0][0][1]); w0.y = pk2(v[0][0][2], v[0][0][3]); w0.z = pk2(v[0][1][0], v[0][1][1]); w0.w = pk2(v[0][1][2], v[0][1][3]);
                  w1.x = pk2(v[1][0][0], v[1][0][1]); w1.y = pk2(v[1][0][2], v[1][0][3]); w1.z = pk2(v[1][1][0], v[1][1][1]); w1.w = pk2(v[1][1][2], v[1][1][3]);
                  if (sg >= 3 && sg <= 5) stage_store_128<false>(sw, fr, lane_, 16 * fq, w0, 64 + 16 * fq, w1, (unsigned char*)(ob + (size_t)rb * 512 + cb), 1024);
                  else stage_store_128<true>(sw, fr, lane_, 16 * fq, w0, 64 + 16 * fq, w1, (unsigned char*)(ob + (size_t)rb * 512 + cb), 1024); }
                if (fo) { float* f0 = fo + (size_t)(prompt ? rb : rb - mp) * 512 + cb;
#pragma unroll
                    for (int bj = 0; bj < 2; ++bj) stage_store_128(sw, fr, lane_, 32 * fq, __builtin_bit_cast(u32x4, v[bj][0]), 32 * fq + 16, __builtin_bit_cast(u32x4, v[bj][1]), (unsigned char*)(f0 + 32 * bj), 2048); }
            }
        }
    }
};
struct EpiPle {
    static constexpr bool PERM = true, AFTER_DRAIN = false;
    bf16_t* eraw; float* ess; PG8_LAS unsigned char* stg;
    __device__ __forceinline__ void operator()(const f32x4 (&acc)[2][2][4][2], const Unit& u, int wr, int wc, int fr, int fq) const {
        asm volatile("" : "+v"(fr), "+v"(fq));
        const int lane_ = fr + 16 * fq; PG8_LAS unsigned char* sw = stg + (wr * 4 + wc) * STG_WAVE;
        const int cb = u.pn * BM + wc * 64;
#pragma unroll
        for (int ai = 0; ai < 2; ++ai)
#pragma unroll
            for (int m = 0; m < 4; ++m) {
                const int rb = u.pm * BM + wr * 64 + ai * HALF + m * 16; float ss = 0.f; u32x4 w[2];
#pragma unroll
                for (int bj = 0; bj < 2; ++bj) { const f32x4 a = acc[ai][bj][m][0], b = acc[ai][bj][m][1];
                    ss += (a[0] * a[0] + a[1] * a[1]) + (a[2] * a[2] + a[3] * a[3]); ss += (b[0] * b[0] + b[1] * b[1]) + (b[2] * b[2] + b[3] * b[3]);
                    w[bj].x = pk2(a[0], a[1]); w[bj].y = pk2(a[2], a[3]); w[bj].z = pk2(b[0], b[1]); w[bj].w = pk2(b[2], b[3]); }
                stage_store_128(sw, fr, lane_, 16 * fq, w[0], 64 + 16 * fq, w[1], (unsigned char*)(eraw + (size_t)rb * 1024 + cb), 2048);
                ss += __shfl_xor(ss, 16); ss += __shfl_xor(ss, 32);
                if (fq == 0) ess[(size_t)(rb + fr) * 16 + u.pn * 4 + wc] = ss;
            }
    }
};
struct EpiOut {
    static constexpr bool PERM = true, AFTER_DRAIN = false;
    const bf16_t* xb; bf16_t* hb; PG8_LAS unsigned char* stg;
    __device__ __forceinline__ void operator()(const f32x4 (&acc)[2][2][4][2], const Unit& u, int wr, int wc, int fr, int fq) const {
        asm volatile("" : "+v"(fr), "+v"(fq));
        const int lane_ = fr + 16 * fq; PG8_LAS unsigned char* sw = stg + (wr * 4 + wc) * STG_WAVE;
        const int cb = u.pn * BM + wc * 64;
        constexpr int PD = 3;
        u32x4 xq[8][2];
#pragma unroll
        for (int it = 0; it < PD; ++it)
#pragma unroll
            for (int bj = 0; bj < 2; ++bj) xq[it][bj] = __builtin_nontemporal_load((const u32x4*)(xb + (size_t)(u.pm * BM + wr * 64 + (it >> 2) * HALF + (it & 3) * 16 + fr) * 1024 + cb + 8 * fq + 32 * bj));
#pragma unroll
        for (int it = 0; it < 8; ++it) {
            const int ai = it >> 2, m = it & 3;
            if (it + PD < 8) {
#pragma unroll
                for (int bj = 0; bj < 2; ++bj) xq[(it + PD) & 7][bj] = __builtin_nontemporal_load((const u32x4*)(xb + (size_t)(u.pm * BM + wr * 64 + ((it + PD) >> 2) * HALF + ((it + PD) & 3) * 16 + fr) * 1024 + cb + 8 * fq + 32 * bj));
            }
            const int rb = u.pm * BM + wr * 64 + ai * HALF + m * 16;
            u32x4 w[2];
#pragma unroll
            for (int bj = 0; bj < 2; ++bj) { const f32x4 a = acc[ai][bj][m][0], b = acc[ai][bj][m][1]; const u32x4 x = xq[it][bj];
                w[bj].x = pk2(bflo(x.x) + a[0], bfhi(x.x) + a[1]); w[bj].y = pk2(bflo(x.y) + a[2], bfhi(x.y) + a[3]); w[bj].z = pk2(bflo(x.z) + b[0], bfhi(x.z) + b[1]); w[bj].w = pk2(bflo(x.w) + b[2], bfhi(x.w) + b[3]); }
            stage_store_128<false>(sw, fr, lane_, 16 * fq, w[0], 64 + 16 * fq, w[1], (unsigned char*)(hb + (size_t)rb * 1024 + cb), 2048);
        }
    }
};
struct EpiGate {
    static constexpr bool PERM = true, AFTER_DRAIN = false;
    float* y; const bf16_t* hb; const bf16_t* eraw; const float* rstde; const float* gple; PG8_LAS unsigned char* stg;
    __device__ __forceinline__ void operator()(const f32x4 (&acc)[2][2][4][2], const Unit& u, int wr, int wc, int fr, int fq) const {
        asm volatile("" : "+v"(fr), "+v"(fq));
        const int lane_ = fr + 16 * fq; PG8_LAS unsigned char* sw = stg + (wr * 4 + wc) * STG_WAVE;
        const int cb = u.pn * BM + wc * 64;
        f32x4 gp[2][2];
#pragma unroll
        for (int bj = 0; bj < 2; ++bj)
#pragma unroll
            for (int n = 0; n < 2; ++n) gp[bj][n] = *(const f32x4*)(gple + cb + 32 * bj + 8 * fq + 4 * n);
        float rev[2][4];
#pragma unroll
        for (int ai = 0; ai < 2; ++ai)
#pragma unroll
            for (int m = 0; m < 4; ++m) rev[ai][m] = rstde[u.pm * BM + wr * 64 + ai * HALF + m * 16 + fr];
        constexpr int PD = 2;
        u32x4 eq[8][2], hq[8][2];
#pragma unroll
        for (int it = 0; it < PD; ++it)
#pragma unroll
            for (int bj = 0; bj < 2; ++bj) { const size_t o = (size_t)(u.pm * BM + wr * 64 + (it >> 2) * HALF + (it & 3) * 16 + fr) * 1024 + cb + 8 * fq + 32 * bj;
                eq[it][bj] = __builtin_nontemporal_load((const u32x4*)(eraw + o)); hq[it][bj] = *(const u32x4*)(hb + o); }
#pragma unroll
        for (int it = 0; it < 8; ++it) {
            const int ai = it >> 2, m = it & 3;
            if (it + PD < 8) {
#pragma unroll
                for (int bj = 0; bj < 2; ++bj) { const size_t o = (size_t)(u.pm * BM + wr * 64 + ((it + PD) >> 2) * HALF + ((it + PD) & 3) * 16 + fr) * 1024 + cb + 8 * fq + 32 * bj;
                    eq[(it + PD) & 7][bj] = __builtin_nontemporal_load((const u32x4*)(eraw + o)); hq[(it + PD) & 7][bj] = *(const u32x4*)(hb + o); }
            }
            const int rb = u.pm * BM + wr * 64 + ai * HALF + m * 16; const float re = rev[ai][m];
#pragma unroll
            for (int bj = 0; bj < 2; ++bj) {
                const u32x4 e = eq[it][bj], h = hq[it][bj];
                const f32x4 a = acc[ai][bj][m][0], b = acc[ai][bj][m][1];
                const f32x4 e0 = (f32x4){bflo(e.x), bfhi(e.x), bflo(e.y), bfhi(e.y)}, e1 = (f32x4){bflo(e.z), bfhi(e.z), bflo(e.w), bfhi(e.w)};
                const f32x4 h0 = (f32x4){bflo(h.x), bfhi(h.x), bflo(h.y), bfhi(h.y)}, h1 = (f32x4){bflo(h.z), bfhi(h.z), bflo(h.w), bfhi(h.w)};
                f32x4 s0, s1;
#pragma unroll
                for (int j = 0; j < 4; ++j) { s0[j] = fast_sigmoid(a[j]); s1[j] = fast_sigmoid(b[j]); }
                const f32x4 y0 = h0 + s0 * (e0 * re * gp[bj][0]), y1 = h1 + s1 * (e1 * re * gp[bj][1]);
                stage_store_128(sw, fr, lane_, 32 * fq, __builtin_bit_cast(u32x4, y0), 32 * fq + 16, __builtin_bit_cast(u32x4, y1), (unsigned char*)(y + (size_t)rb * 1024 + cb + 32 * bj), 4096); }
        }
    }
};
struct FillOrder {
    int nN, nwg, idx, nfree;
    __host__ __device__ void init(int M, int N, int G, int c, int nprev) { nN = N / BM; nwg = (M / BM) * nN; const int r = nprev % G; if (r == 0) { idx = c; nfree = G; } else { idx = c - r; nfree = G - r; } }
    __host__ __device__ bool next(int i, Unit& u) const { if (idx < 0) return false; const long L = (long)i * nfree + idx; if (L >= nwg) return false; u.pm = (int)(L / nN); u.pn = (int)(L % nN); return true; }
    __device__ __forceinline__ void a_ready(const Unit&) const {}
    __device__ __forceinline__ void done(const Unit&) const {}
};
}
constexpr int NWAVES = 8;
#ifndef MK_N_LAUNCHES
#define MK_N_LAUNCHES 1
#endif
constexpr int N_LAUNCHES = MK_N_LAUNCHES;
constexpr int PER_PHASE = 6;

constexpr int MP = 32768, MS = 1024, M = MP + MS;
constexpr int D = 1024, DIN = 3584, DSEG = 512, NH = 8, HD = 64, NGRP = 4, GA = 128, DPLE = 256, SEQ = 2048, NBP = 16, NBS = 128, TS = 8, WB = 2048;
constexpr size_t OUT_Y = 0, OUT_KWIN = (size_t)M * D, OUT_VWIN = OUT_KWIN + (size_t)MP * DSEG, OUT_KNEW = OUT_VWIN + (size_t)MP * DSEG, OUT_VNEW = OUT_KNEW + (size_t)MS * DSEG,
                 OUT_VACH = OUT_VNEW + (size_t)MS * DSEG, OUT_END = OUT_VACH + (size_t)MS * DSEG;
static_assert(OUT_END == 69730304, "output size");
using pg8::pk2; using pg8::bflo; using pg8::bfhi; using pg8::RMS_EPS; using pg8::fast_sigmoid;

constexpr size_t MiB = 1u << 20;
constexpr size_t WS_CTL = 0, CTL_ZERO_BYTES = 64 * 1024;
constexpr size_t WS_WIN = 2 * MiB, WS_WOUT = 10 * MiB, WS_WPLE = 12 * MiB, WS_WG = 13 * MiB, WS_WS = 15 * MiB;
constexpr size_t WS_RSTD = 15 * MiB + 512 * 1024, WS_RSTDE = 15 * MiB + 768 * 1024;
constexpr size_t WS_ESS = 16 * MiB;
constexpr size_t WS_PA = 20 * MiB, WS_PAL = 22 * MiB, WS_PBC = 23 * MiB, WS_PBCL = 39 * MiB;
constexpr size_t WS_XB = 40 * MiB, WS_PB = 106 * MiB, WS_SEG = 123 * MiB, SEG_BYTES = 33 * MiB;
constexpr size_t WS_MIX = 354 * MiB, WS_HB = 420 * MiB, WS_ERAW = 486 * MiB, WS_PO = 552 * MiB, WS_PL = 648 * MiB, WS_END = 652 * MiB;
static_assert((size_t)M * DSEG * 2 == SEG_BYTES && (size_t)M * D * 2 == 66 * MiB && (size_t)M * 16 * 4 <= 4 * MiB && (size_t)DIN * D * 2 <= 8 * MiB, "d_ws map");
enum Seg { SG_U = 0, SG_VA = 1, SG_ZA = 2, SG_Q = 3, SG_K = 4, SG_V = 5, SG_ZB = 6 };
constexpr int CW_TMO = 0, CW_CODE = 1, CW_QHEAD = 64, CW_BAR = 4096;

constexpr int RING_OFF = 0, RING_BYTES = 131072;
constexpr int LDSCTL_OFF = 147 * 1024, MISC_OFF = LDSCTL_OFF + 320;
constexpr int LDS_BYTES = 151552;
static_assert(MISC_OFF + 128 <= LDS_BYTES, "LDS map");

#define GAS __attribute__((address_space(1)))
#define LAS __attribute__((address_space(3)))
typedef unsigned short bf16;
typedef unsigned v4u __attribute__((ext_vector_type(4)));
typedef unsigned v2u __attribute__((ext_vector_type(2)));
typedef float f32x4 __attribute__((ext_vector_type(4)));
typedef float f32x16 __attribute__((ext_vector_type(16)));
typedef short bf16x8 __attribute__((ext_vector_type(8)));
typedef short s16x4 __attribute__((ext_vector_type(4)));
typedef GAS unsigned gu32;
#define RLX_AGENT __ATOMIC_RELAXED, __HIP_MEMORY_SCOPE_AGENT
#define LDS_WAIT() asm volatile("s_waitcnt lgkmcnt(0)" ::: "memory")
#define VM_WAIT() asm volatile("s_waitcnt vmcnt(0)" ::: "memory")
#define XB_TMO      128
#define XB_XCNT(j)  (256  + 64 * (j))
#define XB_XSUB(j)  (1280 + 64 * (j))
#define XB_XGEN(j)  (2304 + 64 * (j))
#define XB_TOP      3328
#define XB_TOPGEN   3392
#define XCD_BAR_WORDS 3456
#define XB_SPIN_CAP (1u << 18)

__device__ __forceinline__ unsigned xb_ld(unsigned* p)              { return __hip_atomic_load(p, __ATOMIC_RELAXED, __HIP_MEMORY_SCOPE_AGENT); }
__device__ __forceinline__ unsigned xb_add(unsigned* p, unsigned v) { return __hip_atomic_fetch_add(p, v, __ATOMIC_RELAXED, __HIP_MEMORY_SCOPE_AGENT); }
__device__ __forceinline__ unsigned xb_xcc_id() { return (unsigned)__builtin_amdgcn_s_getreg((3 << 11) | 20) & 0xFu; }
#define XB_SPIN(cond, bar) do { unsigned _sp = 0; while (cond) { __builtin_amdgcn_s_sleep(1); \
    if ((++_sp & 255u) == 0u) { if (xb_ld(&(bar)[XB_TMO])) break; if (_sp > XB_SPIN_CAP) { atomicAdd(&(bar)[XB_TMO], 1u); break; } } } } while (0)

struct XcdBarrier {
    int wave;
    unsigned* bar; unsigned x;
    volatile LAS unsigned* st;
};

__device__ __forceinline__ XcdBarrier xcd_barrier_post(unsigned* bar, volatile LAS unsigned* st) {
    XcdBarrier b; b.wave = (int)__builtin_amdgcn_readfirstlane((int)threadIdx.x >> 6); b.bar = bar; b.x = xb_xcc_id(); b.st = st;
    if (threadIdx.x == 0) (void)xb_add(&bar[XB_XCNT(b.x)], 1u);
    return b;
}
__device__ __forceinline__ void xcd_barrier_complete(unsigned* bar, unsigned x, unsigned& nloc, unsigned& nx) {
    const unsigned G = gridDim.x * gridDim.y * gridDim.z;
    unsigned sum, cnt, mine, sp = 0u;
    for (;;) {
        sum = 0u; cnt = 0u; mine = 0u;
#pragma unroll
        for (unsigned j = 0; j < 16; ++j) { const unsigned c = xb_ld(&bar[XB_XCNT(j)]); sum += c; cnt += (c > 0u) ? 1u : 0u; mine = (j == x) ? c : mine; }
        if (sum == G) break;
        __builtin_amdgcn_s_sleep(1);
        if ((++sp & 255u) == 0u) { if (xb_ld(&bar[XB_TMO])) break; if (sp > XB_SPIN_CAP) { atomicAdd(&bar[XB_TMO], 1u); break; } }
    }
    nloc = mine > 0u ? mine : 1u; nx = cnt > 0u ? cnt : 1u;
}

__device__ __forceinline__ void xcd_barrier(const XcdBarrier& b) {
    asm volatile("s_waitcnt vmcnt(0)" ::: "memory");
    __syncthreads();
    if (b.wave == 0 && __builtin_amdgcn_mbcnt_hi(~0u, __builtin_amdgcn_mbcnt_lo(~0u, 0u)) == 0u) {
        unsigned* bar = b.bar;
        __builtin_amdgcn_s_waitcnt(0);
        unsigned nloc = b.st[0], nx = b.st[1];
        if (nloc == 0u) { xcd_barrier_complete(bar, b.x, nloc, nx); b.st[0] = nloc; b.st[1] = nx; }
        const unsigned old = xb_add(&bar[XB_XSUB(b.x)], 1u);
        const unsigned gen = old / nloc;
        if (old + 1u == (gen + 1u) * nloc) {
            __builtin_amdgcn_fence(__ATOMIC_RELEASE, "agent");
            asm volatile("s_waitcnt vmcnt(0)" ::: "memory");
            const unsigned og = xb_add(&bar[XB_TOP], 1u);
            const unsigned tg = og / nx;
            if (og + 1u == (tg + 1u) * nx) xb_add(&bar[XB_TOPGEN], 1u);
            else XB_SPIN(xb_ld(&bar[XB_TOPGEN]) == tg, bar);
            __builtin_amdgcn_fence(__ATOMIC_ACQUIRE, "agent");
            xb_add(&bar[XB_XGEN(b.x)], 1u);
            asm volatile("s_waitcnt vmcnt(0)" ::: "memory");
        } else {
            XB_SPIN(xb_ld(&bar[XB_XGEN(b.x)]) == gen, bar);
            __builtin_amdgcn_fence(__ATOMIC_ACQUIRE, "agent");
            asm volatile("s_waitcnt vmcnt(0)" ::: "memory");
        }
    }
    __syncthreads();
}
struct Frame {
    LAS unsigned char* lds;
    volatile LAS unsigned* MISC;
    gu32* ctl;
    int wave;
    int vcu, G;
    float* out;
    unsigned char* ws;
};
__device__ __forceinline__ const float* inp(int k) { auto p = __builtin_amdgcn_kernarg_segment_ptr(); asm volatile("" : "+s"(p)); return ((const float* const*)p)[k]; }
__device__ __forceinline__ int lane_id() { return (int)__builtin_amdgcn_mbcnt_hi(~0u, __builtin_amdgcn_mbcnt_lo(~0u, 0u)); }
__device__ __forceinline__ bf16* segp(const Frame& F, int sg) { return ((bf16*)(F.ws + WS_SEG)) + (size_t)sg * (SEG_BYTES / 2); }
__device__ __forceinline__ float wave_sum(float v) {
#pragma unroll
    for (int o = 1; o < 64; o <<= 1) v += __shfl_xor(v, o);
    return v;
}

__device__ __forceinline__ void p0_transpose_item(const float* W, int K, int N, bf16* WT, const float* kscale, bool permute, LAS float* scr, int item, int lane) {
    const int nblk = N / 32, kb = item / nblk, nb = item % nblk, k0 = 64 * kb, n0 = 32 * nb;
#pragma unroll 8
    for (int i = 0; i < 32; ++i) { const int kk = 2 * i + (lane >> 5); scr[kk * 33 + (lane & 31)] = __builtin_nontemporal_load(W + (size_t)(k0 + kk) * N + n0 + (lane & 31)); }
    LDS_WAIT(); asm volatile("" ::: "memory");
    const int c = lane & 7;
    float ks[8];
#pragma unroll
    for (int e = 0; e < 8; ++e) ks[e] = kscale ? kscale[k0 + 8 * c + e] : 1.0f;
#pragma unroll
    for (int j = 0; j < 4; ++j) { const int n = (lane >> 3) + 8 * j; const LAS float* s = scr + (8 * c) * 33 + n;
        v4u o; o.x = pk2(s[0 * 33] * ks[0], s[1 * 33] * ks[1]); o.y = pk2(s[2 * 33] * ks[2], s[3 * 33] * ks[3]); o.z = pk2(s[4 * 33] * ks[4], s[5 * 33] * ks[5]); o.w = pk2(s[6 * 33] * ks[6], s[7 * 33] * ks[7]);
        int col = n0 + n, row = col;
        if (permute) { const int ol = col & 255; row = (col & ~255) + 128 * ((ol >> 5) & 1) + 32 * (ol >> 6) + (ol & 31); }
        *(GAS v4u*)(WT + (size_t)row * K + k0 + 8 * c) = o; }
    LDS_WAIT(); asm volatile("" ::: "memory");
}
__device__ __forceinline__ void p0_prologue(Frame& F) {
    const int lane = lane_id();
    LAS float* scr = (LAS float*)(F.lds + RING_OFF + F.wave * 16384);
    const int gw = F.vcu * NWAVES + F.wave, NGW = F.G * NWAVES;
    constexpr int I_IN = (D / 64) * (DIN / 32), I_OUT = (D / 64) * (D / 32), I_PLE = (DPLE / 64) * (D / 32), I_G = (D / 64) * (D / 32);
    constexpr int NITEMS = I_IN + I_OUT + I_PLE + I_G;
    for (int it = gw; it < NITEMS; it += NGW) {
        int r = it;
        if (r < I_IN) { p0_transpose_item(inp(7), D, DIN, ((bf16*)(F.ws + WS_WIN)), inp(6), true, scr, r, lane); continue; } r -= I_IN;
        if (r < I_OUT) { p0_transpose_item(inp(15), D, D, ((bf16*)(F.ws + WS_WOUT)), nullptr, true, scr, r, lane); continue; } r -= I_OUT;
        if (r < I_PLE) { p0_transpose_item(inp(16), DPLE, D, ((bf16*)(F.ws + WS_WPLE)), nullptr, true, scr, r, lane); continue; } r -= I_PLE;
        p0_transpose_item(inp(18), D, D, ((bf16*)(F.ws + WS_WG)), nullptr, true, scr, r, lane);
    }
    for (int i = gw * 64 + lane; i < NGRP * 128 * 128; i += NGW * 64) { const int s = i & 127, t = (i >> 7) & 127; const float w = (s <= t) ? inp(8)[i] : 0.f; ((bf16*)(F.ws + WS_WS))[i] = (bf16)(pk2(w, 0.f) & 0xffffu); }
    for (int m = gw; m < M; m += NGW) {
        const float* xrow = (m < MP) ? inp(0) + (size_t)m * D : inp(1) + (size_t)(m - MP) * D;
        const GAS f32x4* xr = (const GAS f32x4*)xrow + lane;
        f32x4 v[4]; float s2 = 0.f;
#pragma unroll
        for (int j = 0; j < 4; ++j) { v[j] = __builtin_nontemporal_load((const f32x4*)(xr + 64 * j)); s2 += (v[j].x * v[j].x + v[j].y * v[j].y) + (v[j].z * v[j].z + v[j].w * v[j].w); }
        s2 = wave_sum(s2);
        if (lane == 0) ((float*)(F.ws + WS_RSTD))[m] = 1.0f / sqrtf(s2 * (1.0f / D) + RMS_EPS);
        GAS v2u* o8 = (GAS v2u*)(((bf16*)(F.ws + WS_XB)) + (size_t)m * D) + lane;
#pragma unroll
        for (int j = 0; j < 4; ++j) { v2u o; o.x = pk2(v[j].x, v[j].y); o.y = pk2(v[j].z, v[j].w); o8[64 * j] = o; }
    }
    for (int i = gw; i < M / 2; i += NGW) {
        const int m = 2 * i; const float* prow = (m < MP) ? inp(4) + (size_t)m * DPLE : inp(5) + (size_t)(m - MP) * DPLE;
        const GAS f32x4* pr = (const GAS f32x4*)prow + 2 * lane; const f32x4 a = __builtin_nontemporal_load((const f32x4*)pr), b = __builtin_nontemporal_load((const f32x4*)(pr + 1));
        v4u o; o.x = pk2(a.x, a.y); o.y = pk2(a.z, a.w); o.z = pk2(b.x, b.y); o.w = pk2(b.z, b.w);
        *((GAS v4u*)(((bf16*)(F.ws + WS_PB)) + (size_t)m * DPLE) + lane) = o;
    }
}

#define DPP_F(v, ctrl) __builtin_bit_cast(float, __builtin_amdgcn_update_dpp(0, __builtin_bit_cast(int, (v)), (ctrl), 0xf, 0xf, true))
__device__ __forceinline__ void glds16_nt(const void* gsrc, unsigned lds_dst) { unsigned keep;
    asm volatile("s_mov_b32 %0, m0\n\ts_mov_b32 m0, %2\n\ts_nop 0\n\tglobal_load_lds_dwordx4 %1, off nt\n\ts_mov_b32 m0, %0" : "=&s"(keep) : "v"(gsrc), "s"(lds_dst) : "memory"); }
__device__ __forceinline__ float head_sum8(float s) { s += DPP_F(s, 0xB1); s += DPP_F(s, 0x4E); s += DPP_F(s, 0x141); return s; }
__device__ __forceinline__ void ld_q8(const bf16* qrow, int lane, float (&q)[8]) {
    const v4u w = *(const GAS v4u*)(qrow + 8 * lane);
    q[0] = bflo(w.x); q[1] = bfhi(w.x); q[2] = bflo(w.y); q[3] = bfhi(w.y); q[4] = bflo(w.z); q[5] = bfhi(w.z); q[6] = bflo(w.w); q[7] = bfhi(w.w);
}
struct SRow4 { f32x4 k0[4], k1[4], v0[4], v1[4]; };
__device__ __forceinline__ void srow4_load_nt(SRow4& R, const float* kp, const float* vp, size_t rstep) {
#pragma unroll
    for (int u = 0; u < 4; ++u) { R.k0[u] = __builtin_nontemporal_load((const f32x4*)(kp + u * rstep)); R.k1[u] = __builtin_nontemporal_load((const f32x4*)(kp + u * rstep + 4));
        R.v0[u] = __builtin_nontemporal_load((const f32x4*)(vp + u * rstep)); R.v1[u] = __builtin_nontemporal_load((const f32x4*)(vp + u * rstep + 4)); }
}
__device__ __forceinline__ void srow4_acc(const SRow4& R, int u, const float (&q)[8], float mult, float (&o)[8], float& l) {
    float s = (q[0] * R.k0[u].x + q[1] * R.k0[u].y) + (q[2] * R.k0[u].z + q[3] * R.k0[u].w) + (q[4] * R.k1[u].x + q[5] * R.k1[u].y) + (q[6] * R.k1[u].z + q[7] * R.k1[u].w);
    s = head_sum8(s); const float p = mult * __builtin_amdgcn_exp2f(s); l += p;
    o[0] += p * R.v0[u].x; o[1] += p * R.v0[u].y; o[2] += p * R.v0[u].z; o[3] += p * R.v0[u].w; o[4] += p * R.v1[u].x; o[5] += p * R.v1[u].y; o[6] += p * R.v1[u].z; o[7] += p * R.v1[u].w;
}
#define S_FENCE() asm volatile("" ::: "memory")
__device__ __forceinline__ void samp_unit(Frame& F, int b) {
    int lane = lane_id(); asm volatile("" : "+v"(lane));
    const int w = F.wave; const size_t m0 = (size_t)MP + b * TS;
    const float* ck = ((const float*)inp(2)) + (size_t)b * WB * DSEG + 8 * lane; const float* cv = ((const float*)inp(3)) + (size_t)b * WB * DSEG + 8 * lane;
    const float* nk = F.out + OUT_KNEW + (size_t)b * TS * DSEG + 8 * lane; const float* nv = F.out + OUT_VNEW + (size_t)b * TS * DSEG + 8 * lane;
    float oa[8], la = 0.f;
#pragma unroll
    for (int e = 0; e < 8; ++e) oa[e] = 0.f;
    float ob0[8], ob1[8], lb0 = 0.f, lb1 = 0.f;
#pragma unroll
    for (int e = 0; e < 8; ++e) { ob0[e] = 0.f; ob1[e] = 0.f; }
    LAS unsigned char* ring = F.lds + RING_OFF + w * 16384; const unsigned ring0 = (unsigned)(uintptr_t)ring;
#define S_DMA_ROW(slot, kp_, vp_) do { const unsigned d_ = (unsigned)__builtin_amdgcn_readfirstlane((int)(ring0 + (slot) * 4096)); \
        glds16_nt((kp_) + 4 * lane_, d_); glds16_nt((kp_) + 256 + 4 * lane_, d_ + 1024); glds16_nt((vp_) + 4 * lane_, d_ + 2048); glds16_nt((vp_) + 256 + 4 * lane_, d_ + 3072); } while (0)
#define S_LDS_ROW(slot, K0, K1, V0, V1) do { const LAS unsigned char* p_ = ring + (slot) * 4096 + 32 * lane_; K0 = *(const LAS f32x4*)p_; K1 = *(const LAS f32x4*)(p_ + 16); V0 = *(const LAS f32x4*)(p_ + 2048); V1 = *(const LAS f32x4*)(p_ + 2064); } while (0)
    const int lane_ = lane;
    const float* ck0 = ((const float*)inp(2)) + (size_t)b * WB * DSEG; const float* cv0 = ((const float*)inp(3)) + (size_t)b * WB * DSEG;
    { float q[8]; ld_q8(segp(F, SG_Q) + (m0 + w) * DSEG, lane, q);
      asm volatile("s_waitcnt vmcnt(0)" ::: "memory");
      const size_t rs = (size_t)16 * DSEG; const float* kb = ck0 + (size_t)w * DSEG; const float* vb = cv0 + (size_t)w * DSEG;
      S_DMA_ROW(0, kb, vb); S_DMA_ROW(1, kb + rs, vb + rs); S_DMA_ROW(2, kb + 2 * rs, vb + 2 * rs);
#pragma unroll 4
      for (int i = 0; i < 96; ++i) {
          { const int in = (i + 3 < 96) ? i + 3 : 95; S_DMA_ROW((i + 3) & 3, kb + (size_t)in * rs, vb + (size_t)in * rs); }
          asm volatile("s_waitcnt vmcnt(12)" ::: "memory");
          { SRow4 R; S_LDS_ROW(i & 3, R.k0[0], R.k1[0], R.v0[0], R.v1[0]); srow4_acc(R, 0, q, 1.0f, oa, la); }
          asm volatile("s_waitcnt lgkmcnt(0)" ::: "memory");
      }
      asm volatile("s_waitcnt vmcnt(0)" ::: "memory"); }
    { float q0[8], q1[8]; const int t0 = w & 3, t1 = t0 + 4; ld_q8(segp(F, SG_Q) + (m0 + t0) * DSEG, lane, q0); ld_q8(segp(F, SG_Q) + (m0 + t1) * DSEG, lane, q1);
      asm volatile("s_waitcnt vmcnt(0)" ::: "memory");
      const size_t rs = (size_t)8 * DSEG; const float* kb = ck0 + (size_t)(1536 + w) * DSEG; const float* vb = cv0 + (size_t)(1536 + w) * DSEG;
      S_DMA_ROW(0, kb, vb); S_DMA_ROW(1, kb + rs, vb + rs); S_DMA_ROW(2, kb + 2 * rs, vb + 2 * rs);
#pragma unroll 4
      for (int i = 0; i < 48; ++i) {
          { const int in = (i + 3 < 48) ? i + 3 : 47; S_DMA_ROW((i + 3) & 3, kb + (size_t)in * rs, vb + (size_t)in * rs); }
          asm volatile("s_waitcnt vmcnt(12)" ::: "memory");
          { SRow4 R; S_LDS_ROW(i & 3, R.k0[0], R.k1[0], R.v0[0], R.v1[0]); const int rho = 1536 + w + 8 * i, d0 = WB + t0 - rho, d1 = WB + t1 - rho;
            srow4_acc(R, 0, q0, (d0 <= 512 ? 1.0f : 0.0f) + ((d0 & 15) == 0 ? 1.0f : 0.0f), ob0, lb0); srow4_acc(R, 0, q1, (d1 <= 512 ? 1.0f : 0.0f) + ((d1 & 15) == 0 ? 1.0f : 0.0f), ob1, lb1); }
          asm volatile("s_waitcnt lgkmcnt(0)" ::: "memory");
      }
      asm volatile("s_waitcnt vmcnt(0)" ::: "memory"); }
#undef S_DMA_ROW
#undef S_LDS_ROW
    __syncthreads();
    float q[8][8], o[8][8], l[8];
#pragma unroll
    for (int t = 0; t < 8; ++t) { ld_q8(segp(F, SG_Q) + (m0 + t) * DSEG, lane, q[t]);
        const bool a0 = (t == (w & 3)), a1 = (t == (w & 3) + 4);
        l[t] = a0 ? lb0 : (a1 ? lb1 : 0.f);
#pragma unroll
        for (int e = 0; e < 8; ++e) o[t][e] = a0 ? ob0[e] : (a1 ? ob1[e] : 0.f); }
    for (int i0 = 0; i0 < 20; i0 += 4) {
        f32x4 k0[4], k1[4], v0[4], v1[4]; int rho[4];
#pragma unroll
        for (int u = 0; u < 4; ++u) { const int i = i0 + u, ic = i < 16 ? i : 16; rho[u] = (i <= 16) ? 1920 + w + 8 * ic : 100000; const int rr = 1920 + w + 8 * ic;
            const float* kr = (rr < WB) ? ck + (size_t)rr * DSEG : nk + (size_t)(rr - WB) * DSEG; const float* vr = (rr < WB) ? cv + (size_t)rr * DSEG : nv + (size_t)(rr - WB) * DSEG;
            k0[u] = *(const f32x4*)kr; k1[u] = *(const f32x4*)(kr + 4); v0[u] = *(const f32x4*)vr; v1[u] = *(const f32x4*)(vr + 4); }
#pragma unroll
        for (int u = 0; u < 4; ++u) {
#pragma unroll
            for (int t = 0; t < 8; ++t) {
                const int dl = WB + t - rho[u];
                const int mult = (dl >= 0 && dl <= 128 ? 1 : 0) + (dl >= 0 && (dl & 3) == 0 && dl <= 512 ? 1 : 0) + (dl >= 0 && (dl & 15) == 0 ? 1 : 0);
                if (mult) {
                    float s = (q[t][0] * k0[u].x + q[t][1] * k0[u].y) + (q[t][2] * k0[u].z + q[t][3] * k0[u].w) + (q[t][4] * k1[u].x + q[t][5] * k1[u].y) + (q[t][6] * k1[u].z + q[t][7] * k1[u].w);
                    s = head_sum8(s); const float p = (float)mult * __builtin_amdgcn_exp2f(s); l[t] += p;
                    o[t][0] += p * v0[u].x; o[t][1] += p * v0[u].y; o[t][2] += p * v0[u].z; o[t][3] += p * v0[u].w; o[t][4] += p * v1[u].x; o[t][5] += p * v1[u].y; o[t][6] += p * v1[u].z; o[t][7] += p * v1[u].w; }
            }
        }
    }
    LAS float* mb = (LAS float*)(F.lds + RING_OFF);
#pragma unroll
    for (int rnd = 0; rnd < 2; ++rnd) {
#pragma unroll
        for (int tq = 0; tq < 4; ++tq) { LAS float* sl = mb + (w * 4 + tq) * 576 + lane * 9;
#pragma unroll
            for (int e = 0; e < 8; ++e) sl[e] = o[4 * rnd + tq][e];
            sl[8] = l[4 * rnd + tq]; }
        __syncthreads();
        if ((w >> 2) == rnd) { const int tq = w & 3;
#pragma unroll
            for (int ww = 0; ww < 8; ++ww) { const LAS float* sl = mb + (ww * 4 + tq) * 576 + lane * 9;
#pragma unroll
                for (int e = 0; e < 8; ++e) oa[e] += sl[e];
                la += sl[8]; } }
        __syncthreads();
    }
    const float inv = 1.0f / la; float ss = 0.f;
#pragma unroll
    for (int e = 0; e < 8; ++e) { oa[e] *= inv; ss += oa[e] * oa[e]; }
    ss = head_sum8(ss);
    const float rn = 1.0f / sqrtf(ss * (1.0f / HD) + RMS_EPS);
    const f32x4 g0 = *(const f32x4*)(inp(14) + 8 * lane), g1 = *(const f32x4*)(inp(14) + 8 * lane + 4);
    const size_t m = m0 + w;
    const v4u z = *(const GAS v4u*)(segp(F, SG_ZB) + m * DSEG + 8 * lane);
    v4u wv; wv.x = pk2(oa[0] * rn * g0.x * bflo(z.x), oa[1] * rn * g0.y * bfhi(z.x)); wv.y = pk2(oa[2] * rn * g0.z * bflo(z.y), oa[3] * rn * g0.w * bfhi(z.y));
    wv.z = pk2(oa[4] * rn * g1.x * bflo(z.z), oa[5] * rn * g1.y * bfhi(z.z)); wv.w = pk2(oa[6] * rn * g1.z * bflo(z.w), oa[7] * rn * g1.w * bfhi(z.w));
    *(GAS v4u*)(((bf16*)(F.ws + WS_MIX)) + m * D + DSEG + 8 * lane) = wv;
}

constexpr int VN_PITCH = 272, GM_VN = 0, GM_U = 128 * VN_PITCH, GM_Z = 2 * 128 * VN_PITCH, GM_P = 3 * 128 * VN_PITCH;
__device__ __forceinline__ s16x4 tr16(const LAS unsigned char* p) { return __builtin_bit_cast(s16x4, __builtin_amdgcn_ds_read_tr16_b64_v4i16((LAS s16x4*)p)); }
struct GmRegs { v4u rv[4], ru[4], rz[4]; bf16x8 wf[4]; };
__device__ __forceinline__ void gmlp_load(Frame& F, GmRegs& R, int m0, int g, int lane, int w) {
    const int tid = w * 64 + lane, t = 16 * w + (lane & 15), gq4 = lane >> 4;
    const size_t roff = (size_t)(m0 + (tid >> 4)) * DSEG + g * GA + 8 * (tid & 15);
    const bf16* pv = segp(F, SG_VA) + roff; const bf16* pu = segp(F, SG_U) + roff; const bf16* pz = segp(F, SG_ZA) + roff;
#pragma unroll
    for (int i = 0; i < 4; ++i) R.rv[i] = __builtin_nontemporal_load((const v4u*)(pv + (size_t)(32 * i) * DSEG));
    const bf16* wsrow = ((bf16*)(F.ws + WS_WS)) + ((size_t)g * 128 + t) * 128 + 8 * gq4;
#pragma unroll
    for (int ks = 0; ks < 4; ++ks) R.wf[ks] = *(const GAS bf16x8*)(wsrow + 32 * ks);
#pragma unroll
    for (int i = 0; i < 4; ++i) { R.ru[i] = __builtin_nontemporal_load((const v4u*)(pu + (size_t)(32 * i) * DSEG)); R.rz[i] = __builtin_nontemporal_load((const v4u*)(pz + (size_t)(32 * i) * DSEG)); }
}
__device__ __forceinline__ void gmlp_compute(Frame& F, const GmRegs& R, int m0, int g, int lane, int w) {
    LAS unsigned char* img = F.lds + RING_OFF;
    const int tid = w * 64 + lane, srow = tid >> 4, sch = tid & 15;
    const int t = 16 * w + (lane & 15), gq4 = lane >> 4;
    { const LAS float* gv = (const LAS float*)(img + GM_P) + g * GA + 8 * sch;
      const f32x4 ga = *(const LAS f32x4*)gv, gb = *(const LAS f32x4*)(gv + 4);
#pragma unroll
      for (int i = 0; i < 4; ++i) { const v4u r = R.rv[i]; float f[8];
          f[0] = bflo(r.x); f[1] = bfhi(r.x); f[2] = bflo(r.y); f[3] = bfhi(r.y); f[4] = bflo(r.z); f[5] = bfhi(r.z); f[6] = bflo(r.w); f[7] = bfhi(r.w);
          float ss = (f[0] * f[0] + f[1] * f[1]) + (f[2] * f[2] + f[3] * f[3]) + (f[4] * f[4] + f[5] * f[5]) + (f[6] * f[6] + f[7] * f[7]);
          ss += DPP_F(ss, 0xB1); ss += DPP_F(ss, 0x4E); ss += DPP_F(ss, 0x141); ss += DPP_F(ss, 0x140);
          const float rn = 1.0f / sqrtf(ss * (1.0f / GA) + RMS_EPS);
          v4u o; o.x = pk2(f[0] * rn * ga.x, f[1] * rn * ga.y); o.y = pk2(f[2] * rn * ga.z, f[3] * rn * ga.w); o.z = pk2(f[4] * rn * gb.x, f[5] * rn * gb.y); o.w = pk2(f[6] * rn * gb.z, f[7] * rn * gb.w);
          const int off = (32 * i + srow) * VN_PITCH + 16 * sch;
          *(LAS v4u*)(img + GM_VN + off) = o; *(LAS v4u*)(img + GM_U + off) = R.ru[i]; *(LAS v4u*)(img + GM_Z + off) = R.rz[i]; } }
    __syncthreads();
    f32x4 acc[8];
#pragma unroll
    for (int ct = 0; ct < 8; ++ct) acc[ct] = (f32x4){0.f, 0.f, 0.f, 0.f};
    const int q4 = (lane & 15) >> 2, p4 = lane & 3;
    const LAS unsigned char* trb = img + GM_VN + (8 * gq4 + q4) * VN_PITCH + 8 * p4;
    const int nks = (16 * w + 15) / 32 + 1;
#pragma unroll
    for (int ks = 0; ks < 4; ++ks) {
        if (ks < nks) {
#pragma unroll
            for (int ct = 0; ct < 8; ++ct) {
                const s16x4 lo = tr16(trb + (32 * ks) * VN_PITCH + 32 * ct), hi = tr16(trb + (32 * ks + 4) * VN_PITCH + 32 * ct);
                const bf16x8 vf = (bf16x8){lo[0], lo[1], lo[2], lo[3], hi[0], hi[1], hi[2], hi[3]};
                acc[ct] = __builtin_amdgcn_mfma_f32_16x16x32_bf16(vf, R.wf[ks], acc[ct], 0, 0, 0);
            } } }
    const float bs = ((const LAS float*)(img + GM_P))[1024 + g * 128 + t];
    LAS unsigned char* urow = img + GM_U + t * VN_PITCH + 8 * gq4; const LAS unsigned char* zrow = img + GM_Z + t * VN_PITCH + 8 * gq4;
    float a[8][4]; float ss = 0.f;
#pragma unroll
    for (int ct = 0; ct < 8; ++ct) { const v2u uu = *(const LAS v2u*)(urow + 32 * ct);
        a[ct][0] = bflo(uu.x) * (acc[ct][0] + bs); a[ct][1] = bfhi(uu.x) * (acc[ct][1] + bs); a[ct][2] = bflo(uu.y) * (acc[ct][2] + bs); a[ct][3] = bfhi(uu.y) * (acc[ct][3] + bs);
        ss += (a[ct][0] * a[ct][0] + a[ct][1] * a[ct][1]) + (a[ct][2] * a[ct][2] + a[ct][3] * a[ct][3]); }
    ss += __shfl_xor(ss, 16); ss += __shfl_xor(ss, 32);
    const float rn = 1.0f / sqrtf(ss * (1.0f / GA) + RMS_EPS);
#pragma unroll
    for (int ct = 0; ct < 8; ++ct) { const v2u zz = *(const LAS v2u*)(zrow + 32 * ct); const f32x4 go = *(const LAS f32x4*)((const LAS float*)(img + GM_P) + 512 + g * GA + 16 * ct + 4 * gq4);
        v2u o; o.x = pk2(a[ct][0] * rn * go.x * bflo(zz.x), a[ct][1] * rn * go.y * bfhi(zz.x)); o.y = pk2(a[ct][2] * rn * go.z * bflo(zz.y), a[ct][3] * rn * go.w * bfhi(zz.y));
        *(LAS v2u*)(urow + 32 * ct) = o; }
    __syncthreads();
    { bf16* po = ((bf16*)(F.ws + WS_MIX)) + (size_t)(m0 + srow) * D + g * GA + 8 * sch;
#pragma unroll
      for (int i = 0; i < 4; ++i) *(GAS v4u*)(po + (size_t)(32 * i) * D) = *(const LAS v4u*)(img + GM_U + (32 * i + srow) * VN_PITCH + 16 * sch); }
    __syncthreads();
}
__device__ __forceinline__ void gmlp_batch(Frame& F, int m0) {
    int lane = lane_id(); asm volatile("" : "+v"(lane)); const int w = F.wave;
    GmRegs R0, R1;
    { LAS float* pt = (LAS float*)(F.lds + RING_OFF + GM_P); const int tid = w * 64 + lane;
      pt[tid] = inp(10)[tid]; pt[512 + tid] = inp(11)[tid]; pt[1024 + tid] = inp(9)[tid]; }
    gmlp_load(F, R0, m0, 0, lane, w);
    __syncthreads();
    gmlp_load(F, R1, m0, 1, lane, w); gmlp_compute(F, R0, m0, 0, lane, w);
    gmlp_load(F, R0, m0, 2, lane, w); gmlp_compute(F, R1, m0, 1, lane, w);
    gmlp_load(F, R1, m0, 3, lane, w); gmlp_compute(F, R0, m0, 2, lane, w);
    gmlp_compute(F, R1, m0, 3, lane, w);
}
__device__ __forceinline__ void gmlp_sample_task(Frame& F, int b, int g) {
    int lane = lane_id(); asm volatile("" : "+v"(lane)); const int c = g * GA + 2 * lane; const size_t m0 = (size_t)MP + b * TS;
    float vn0[8], vn1[8];
    const float gv0 = inp(10)[c], gv1 = inp(10)[c + 1], go0 = inp(11)[c], go1 = inp(11)[c + 1];
#pragma unroll
    for (int t = 0; t < 8; ++t) {
        const unsigned r = *(const GAS unsigned*)(segp(F, SG_VA) + (m0 + t) * DSEG + c); const float a0 = bflo(r), a1 = bfhi(r);
        const float ss = wave_sum(a0 * a0 + a1 * a1); const float rn = 1.0f / sqrtf(ss * (1.0f / GA) + RMS_EPS);
        vn0[t] = a0 * rn * gv0; vn1[t] = a1 * rn * gv1;
        float* vo = F.out + OUT_VACH + ((size_t)b * TS + t) * DSEG + c; vo[0] = vn0[t]; vo[1] = vn1[t];
    }
#pragma unroll
    for (int t = 0; t < 8; ++t) {
        float m0v = inp(9)[g * 128 + t], m1v = m0v;
#pragma unroll
        for (int s = 0; s <= t; ++s) { const float w = inp(8)[((size_t)g * 128 + t) * 128 + s]; m0v += w * vn0[s]; m1v += w * vn1[s]; }
        const unsigned ur = *(const GAS unsigned*)(segp(F, SG_U) + (m0 + t) * DSEG + c), zr = *(const GAS unsigned*)(segp(F, SG_ZA) + (m0 + t) * DSEG + c);
        const float a0 = bflo(ur) * m0v, a1 = bfhi(ur) * m1v;
        const float ss = wave_sum(a0 * a0 + a1 * a1); const float rn = 1.0f / sqrtf(ss * (1.0f / GA) + RMS_EPS);
        *(GAS unsigned*)(((bf16*)(F.ws + WS_MIX)) + (m0 + t) * D + c) = pk2(a0 * rn * go0 * bflo(zr), a1 * rn * go1 * bfhi(zr));
    }
}

constexpr int TJ_SLOT = 32768, TJ_NSLOT = 4, TJ_X = TJ_NSLOT * TJ_SLOT, TJ_XB = 4608;
static_assert(TJ_X + 4 * TJ_XB <= LDSCTL_OFF, "attention LDS");
__device__ __forceinline__ int crow(int reg, int h2) { return (reg & 3) + 8 * (reg >> 2) + 4 * h2; }
__device__ __forceinline__ void glds16(const void* gsrc, unsigned lds_dst) { unsigned keep;
    asm volatile("s_mov_b32 %0, m0\n\ts_mov_b32 m0, %2\n\ts_nop 0\n\tglobal_load_lds_dwordx4 %1, off\n\ts_mov_b32 m0, %0" : "=&s"(keep) : "v"(gsrc), "s"(lds_dst) : "memory"); }
__device__ __forceinline__ void tj_dma_block(const bf16* Kg, const bf16* Vg, int r, int c, int kb, unsigned lds0, int slot, int w, int lane) {
#pragma unroll
    for (int pi = 0; pi < 2; ++pi) { const int i = w + 8 * pi, row = 8 * i + (lane >> 3), cp = lane & 7;
        const size_t rowoff = (size_t)(c + r * (kb + row)) * DSEG;
        glds16(Kg + rowoff + 8 * (cp ^ ((row >> 1) & 7)), (unsigned)__builtin_amdgcn_readfirstlane((int)(lds0 + slot * TJ_SLOT + i * 1024)));
        glds16(Vg + rowoff + 8 * (cp ^ (4 * ((row >> 1) & 1))), (unsigned)__builtin_amdgcn_readfirstlane((int)(lds0 + slot * TJ_SLOT + 16384 + i * 1024))); }
}
__device__ __forceinline__ void tj_unit(Frame& F, int b, int h, int type, int x) {
    int lane = lane_id(); asm volatile("" : "+v"(lane));
    const int w = F.wave, r32 = lane & 31, h2 = lane >> 5, a = w & 3, hh = w >> 2;
    const int r = (type == 0) ? 1 : (type == 1 ? 4 : 16);
    const size_t hb = (size_t)b * SEQ * DSEG + h * HD;
    const bf16 *Qg = segp(F, SG_Q) + hb, *Kg = segp(F, SG_K) + hb, *Vg = segp(F, SG_V) + hb;
    bf16* PO = (bf16*)(F.ws + WS_PO) + (size_t)type * ((size_t)MP * DSEG) + hb; float* PL = (float*)(F.ws + WS_PL) + (size_t)type * ((size_t)MP * NH) + (size_t)b * SEQ * NH + h;
    LAS unsigned char* L = F.lds + RING_OFF; const unsigned lds0 = (unsigned)(uintptr_t)L;
    const int lead = (type == 0 && x == 1) ? 1 : 0, nent = 8 + lead;
#define TJ_JC(jj) ((type == 0) ? 0 : ((type == 1) ? 2 * x + ((jj) >> 2) : 8 * x + (jj)))
#define TJ_JN(jj) ((type == 0) ? 8 * x + (jj) : ((type == 1) ? ((jj) & 3) : 0))
#define TJ_EC(e) ((type == 0) ? 0 : ((type == 1) ? 2 * x + ((e) >> 2) : 8 * x + (e)))
#define TJ_EN(e) ((type == 0) ? 8 * x + (e) - lead : ((type == 1) ? ((e) & 3) : 0))
#define TJ_QROW(jj) (Qg + (size_t)(TJ_JC(jj) + r * (128 * TJ_JN(jj) + 32 * a + r32)) * DSEG + 8 * h2)
    for (int e = 0; e <= lead + 1; ++e) tj_dma_block(Kg, Vg, r, TJ_EC(e), 128 * TJ_EN(e), lds0, e & 3, w, lane);
    bf16x8 qf[4], qa[4];
    { const bf16* q0 = TJ_QROW(0); const bf16* q1 = TJ_QROW(1);
#pragma unroll
      for (int st = 0; st < 4; ++st) { qf[st] = *(const GAS bf16x8*)(q0 + 16 * st); qa[st] = *(const GAS bf16x8*)(q1 + 16 * st); } }
    asm volatile("s_waitcnt vmcnt(0) lgkmcnt(0)" ::: "memory"); __builtin_amdgcn_s_barrier(); asm volatile("" ::: "memory");
    asm volatile("" : "+v"(qf[0]), "+v"(qf[1]), "+v"(qf[2]), "+v"(qf[3]), "+v"(qa[0]), "+v"(qa[1]), "+v"(qa[2]), "+v"(qa[3]));
    const int q4 = (lane & 15) >> 2, p4 = lane & 3, blk = (lane >> 4) & 1;
    const int kswz = (r32 >> 1) & 7, vswz = 4 * ((q4 >> 1) & 1);
#pragma unroll 1
    for (int jj = 0; jj < 8; ++jj) {
        const int cj = TJ_JC(jj), nj = TJ_JN(jj), ci = jj + lead; const bool has_prev = nj > 0, fin = (hh == (jj & 1));
        const int prev_slot = (ci + 3) & 3, cur_slot = ci & 3;
        bf16x8 qb[4];
        { const int j2 = (jj + 2 < 8) ? jj + 2 : 7; const bf16* q2 = TJ_QROW(j2);
#pragma unroll
          for (int st = 0; st < 4; ++st) asm volatile("global_load_dwordx4 %0, %1, off" : "=v"(qb[st]) : "v"(q2 + 16 * st) : "memory"); }
        const bool dma = (ci + 2 < nent);
        if (dma) tj_dma_block(Kg, Vg, r, TJ_EC(ci + 2), 128 * TJ_EN(ci + 2), lds0, (ci + 2) & 3, w, lane);
        f32x16 o0, o1; float lsum = 0.f;
#pragma unroll
        for (int i = 0; i < 16; ++i) { o0[i] = 0.f; o1[i] = 0.f; }
        const int jlo = fin ? a + 3 : a, jhi = fin ? a + 4 : a + 2;
#pragma unroll 1
        for (int j = jlo; j <= jhi; ++j) {
            if (j < 4 && !has_prev) continue;
            const LAS unsigned char* sl = L + ((j < 4) ? prev_slot : cur_slot) * TJ_SLOT + 32 * (j & 3) * 128;
            bf16x8 kf[4];
#pragma unroll
            for (int st = 0; st < 4; ++st) kf[st] = *(const LAS bf16x8*)(sl + r32 * 128 + 16 * ((2 * st + h2) ^ kswz));
            f32x16 xx;
#pragma unroll
            for (int i = 0; i < 16; ++i) xx[i] = 0.f;
#pragma unroll
            for (int st = 0; st < 4; ++st) xx = __builtin_amdgcn_mfma_f32_32x32x16_bf16(kf[st], qf[st], xx, 0, 0, 0);
            const bool mfirst = (j == a), mlast = (j == a + 4); float ps = 0.f;
            if (mfirst || mlast) {
#pragma unroll
                for (int i = 0; i < 16; ++i) { const int kr = crow(i, h2); const bool valid = (!mfirst || kr >= r32) && (!mlast || kr <= r32);
                    const float p = valid ? __builtin_amdgcn_exp2f(xx[i]) : 0.f; xx[i] = p; ps += p; }
            } else {
#pragma unroll
                for (int i = 0; i < 16; ++i) { const float p = __builtin_amdgcn_exp2f(xx[i]); xx[i] = p; ps += p; }
            }
            lsum += ps;
            v4u pw0, pw1; pw0.x = pk2(xx[0], xx[1]); pw0.y = pk2(xx[2], xx[3]); pw0.z = pk2(xx[4], xx[5]); pw0.w = pk2(xx[6], xx[7]);
            pw1.x = pk2(xx[8], xx[9]); pw1.y = pk2(xx[10], xx[11]); pw1.z = pk2(xx[12], xx[13]); pw1.w = pk2(xx[14], xx[15]);
            const bf16x8 pf0 = __builtin_bit_cast(bf16x8, pw0), pf1 = __builtin_bit_cast(bf16x8, pw1);
            const LAS unsigned char* vb = sl + 16384 + (4 * h2 + q4) * 128 + 8 * (p4 & 1);
            const int ch0 = (2 * blk + (p4 >> 1)) ^ vswz, ch1 = (4 + 2 * blk + (p4 >> 1)) ^ vswz;
            const s16x4 a0 = tr16(vb + 0 * 128 + 16 * ch0), a1 = tr16(vb + 8 * 128 + 16 * ch0), b0 = tr16(vb + 16 * 128 + 16 * ch0), b1 = tr16(vb + 24 * 128 + 16 * ch0);
            const s16x4 c0v = tr16(vb + 0 * 128 + 16 * ch1), c1v = tr16(vb + 8 * 128 + 16 * ch1), d0v = tr16(vb + 16 * 128 + 16 * ch1), d1v = tr16(vb + 24 * 128 + 16 * ch1);
            const bf16x8 v00 = (bf16x8){a0[0], a0[1], a0[2], a0[3], a1[0], a1[1], a1[2], a1[3]}, v01 = (bf16x8){b0[0], b0[1], b0[2], b0[3], b1[0], b1[1], b1[2], b1[3]};
            const bf16x8 v10 = (bf16x8){c0v[0], c0v[1], c0v[2], c0v[3], c1v[0], c1v[1], c1v[2], c1v[3]}, v11 = (bf16x8){d0v[0], d0v[1], d0v[2], d0v[3], d1v[0], d1v[1], d1v[2], d1v[3]};
            o0 = __builtin_amdgcn_mfma_f32_32x32x16_bf16(v00, pf0, o0, 0, 0, 0); o0 = __builtin_amdgcn_mfma_f32_32x32x16_bf16(v01, pf1, o0, 0, 0, 0);
            o1 = __builtin_amdgcn_mfma_f32_32x32x16_bf16(v10, pf0, o1, 0, 0, 0); o1 = __builtin_amdgcn_mfma_f32_32x32x16_bf16(v11, pf1, o1, 0, 0, 0);
        }
        lsum += __shfl_xor(lsum, 32);
        LAS unsigned* xs = (LAS unsigned*)(L + TJ_X + a * TJ_XB) + lane * 17;
        if (!fin) {
#pragma unroll
            for (int i = 0; i < 8; ++i) { xs[i] = pk2(o0[2 * i], o0[2 * i + 1]); xs[8 + i] = pk2(o1[2 * i], o1[2 * i + 1]); }
            xs[16] = __float_as_uint(lsum); }
        if (dma) asm volatile("s_waitcnt vmcnt(4) lgkmcnt(0)" ::: "memory"); else asm volatile("s_waitcnt vmcnt(0) lgkmcnt(0)" ::: "memory");
        __builtin_amdgcn_s_barrier(); asm volatile("" ::: "memory");
        asm volatile("" : "+v"(qb[0]), "+v"(qb[1]), "+v"(qb[2]), "+v"(qb[3]));
#pragma unroll
        for (int st = 0; st < 4; ++st) { qf[st] = qa[st]; qa[st] = qb[st]; }
        if (fin) {
#pragma unroll
            for (int i = 0; i < 8; ++i) { const unsigned ua = xs[i], ub = xs[8 + i]; o0[2 * i] += bflo(ua); o0[2 * i + 1] += bfhi(ua); o1[2 * i] += bflo(ub); o1[2 * i + 1] += bfhi(ub); }
            lsum += __uint_as_float(xs[16]);
            LAS unsigned char* stg = L + TJ_X + a * TJ_XB;
            asm volatile("s_waitcnt lgkmcnt(0)" ::: "memory");
#pragma unroll
            for (int g = 0; g < 4; ++g) { v2u ua; ua.x = pk2(o0[4 * g], o0[4 * g + 1]); ua.y = pk2(o0[4 * g + 2], o0[4 * g + 3]); *(LAS v2u*)(stg + r32 * 144 + 8 * h2 + 16 * g) = ua;
                v2u uc; uc.x = pk2(o1[4 * g], o1[4 * g + 1]); uc.y = pk2(o1[4 * g + 2], o1[4 * g + 3]); *(LAS v2u*)(stg + r32 * 144 + 64 + 8 * h2 + 16 * g) = uc; }
            asm volatile("s_waitcnt lgkmcnt(0)" ::: "memory");
            const size_t pos0 = (size_t)(cj + r * (128 * nj + 32 * a));
#pragma unroll
            for (int i = 0; i < 4; ++i) { const int row = 8 * i + (lane >> 3), ch = lane & 7; const v4u v = *(const LAS v4u*)(stg + row * 144 + 16 * ch);
                *(GAS v4u*)(PO + (pos0 + (size_t)r * row) * DSEG + 8 * ch) = v; }
            if (h2 == 0) PL[(pos0 + (size_t)r * r32) * NH] = lsum;
        }
    }
#undef TJ_JC
#undef TJ_JN
#undef TJ_EC
#undef TJ_EN
#undef TJ_QROW
    asm volatile("s_waitcnt vmcnt(0) lgkmcnt(0)" ::: "memory"); __builtin_amdgcn_s_barrier(); asm volatile("" ::: "memory");
}
__device__ __forceinline__ void attn_finish_row(Frame& F, size_t m, int lane) {
    const bf16* po = (const bf16*)(F.ws + WS_PO) + m * DSEG + 8 * lane; const float* pl = (const float*)(F.ws + WS_PL) + m * NH + (lane >> 3);
    const v4u p0 = *(const GAS v4u*)po, p1 = *(const GAS v4u*)(po + (size_t)MP * DSEG), p2 = *(const GAS v4u*)(po + 2 * (size_t)MP * DSEG);
    const float l = pl[0] + pl[(size_t)MP * NH] + pl[2 * (size_t)MP * NH];
    const v4u z = __builtin_nontemporal_load((const v4u*)(segp(F, SG_ZB) + m * DSEG + 8 * lane));
    const f32x4 g0 = *(const f32x4*)(inp(14) + 8 * lane), g1 = *(const f32x4*)(inp(14) + 8 * lane + 4);
    const float inv = 1.0f / l; float o[8];
    o[0] = (bflo(p0.x) + bflo(p1.x) + bflo(p2.x)) * inv; o[1] = (bfhi(p0.x) + bfhi(p1.x) + bfhi(p2.x)) * inv; o[2] = (bflo(p0.y) + bflo(p1.y) + bflo(p2.y)) * inv; o[3] = (bfhi(p0.y) + bfhi(p1.y) + bfhi(p2.y)) * inv;
    o[4] = (bflo(p0.z) + bflo(p1.z) + bflo(p2.z)) * inv; o[5] = (bfhi(p0.z) + bfhi(p1.z) + bfhi(p2.z)) * inv; o[6] = (bflo(p0.w) + bflo(p1.w) + bflo(p2.w)) * inv; o[7] = (bfhi(p0.w) + bfhi(p1.w) + bfhi(p2.w)) * inv;
    float ss = 0.f;
#pragma unroll
    for (int e = 0; e < 8; ++e) ss += o[e] * o[e];
    ss = head_sum8(ss);
    const float rn = 1.0f / sqrtf(ss * (1.0f / HD) + RMS_EPS);
    v4u wv; wv.x = pk2(o[0] * rn * g0.x * bflo(z.x), o[1] * rn * g0.y * bfhi(z.x)); wv.y = pk2(o[2] * rn * g0.z * bflo(z.y), o[3] * rn * g0.w * bfhi(z.y));
    wv.z = pk2(o[4] * rn * g1.x * bflo(z.z), o[5] * rn * g1.y * bfhi(z.z)); wv.w = pk2(o[6] * rn * g1.z * bflo(z.w), o[7] * rn * g1.w * bfhi(z.w));
    *(GAS v4u*)(((bf16*)(F.ws + WS_MIX)) + m * D + DSEG + 8 * lane) = wv;
}

constexpr int ST_PITCH = 68;
template <int MODE  > __device__ __forceinline__ void small_tile(Frame& F, int tile, const bf16* A, const bf16* Bt) {
    const int lane = lane_id(), w = F.wave, tm = tile >> 4, tn = tile & 15;
    const int l15 = lane & 15, lq = lane >> 4;
    const bf16* ap = A + (size_t)(MP + tm * 64 + l15) * D + 128 * w + 8 * lq;
    const bf16* bp = Bt + (size_t)(tn * 64 + l15) * D + 128 * w + 8 * lq;
    f32x4 acc[4][4];
#pragma unroll
    for (int mi = 0; mi < 4; ++mi)
#pragma unroll
        for (int ni = 0; ni < 4; ++ni) acc[mi][ni] = (f32x4){0.f, 0.f, 0.f, 0.f};
    bf16x8 af[4][4], bfr[4][4];
#pragma unroll
    for (int ks = 0; ks < 4; ++ks)
#pragma unroll
        for (int i = 0; i < 4; ++i) { af[ks][i] = *(const GAS bf16x8*)(ap + (size_t)(16 * i) * D + 32 * ks); bfr[ks][i] = *(const GAS bf16x8*)(bp + (size_t)(16 * i) * D + 32 * ks); }
#pragma unroll
    for (int ks = 0; ks < 4; ++ks)
#pragma unroll
        for (int mi = 0; mi < 4; ++mi)
#pragma unroll
            for (int ni = 0; ni < 4; ++ni) acc[mi][ni] = __builtin_amdgcn_mfma_f32_16x16x32_bf16(bfr[ks][ni], af[ks][mi], acc[mi][ni], 0, 0, 0);
    LAS float* part = (LAS float*)(F.lds + RING_OFF) + w * (64 * ST_PITCH);
#pragma unroll
    for (int mi = 0; mi < 4; ++mi)
#pragma unroll
        for (int ni = 0; ni < 4; ++ni) *(LAS f32x4*)(part + (16 * mi + l15) * ST_PITCH + 16 * ni + 4 * lq) = acc[mi][ni];
    __syncthreads();
    const int r = 8 * w + (lane >> 3), c0 = 8 * (lane & 7);
    f32x4 s0 = (f32x4){0.f, 0.f, 0.f, 0.f}, s1 = s0;
#pragma unroll
    for (int ww = 0; ww < 8; ++ww) { const LAS float* p = (const LAS float*)(F.lds + RING_OFF) + ww * (64 * ST_PITCH) + r * ST_PITCH + c0; s0 += *(const LAS f32x4*)p; s1 += *(const LAS f32x4*)(p + 4); }
    const int slot0 = tn * 64 + c0, oc0 = (slot0 & ~255) + 64 * ((slot0 >> 5) & 3) + 32 * ((slot0 >> 7) & 1) + (slot0 & 31);
    const size_t row = (size_t)MP + tm * 64 + r; const size_t off = row * D + oc0;
    if (MODE == 0) {
        const v4u x = *(const GAS v4u*)(((const bf16*)(F.ws + WS_XB)) + off);
        v4u o; o.x = pk2(bflo(x.x) + s0.x, bfhi(x.x) + s0.y); o.y = pk2(bflo(x.y) + s0.z, bfhi(x.y) + s0.w); o.z = pk2(bflo(x.z) + s1.x, bfhi(x.z) + s1.y); o.w = pk2(bflo(x.w) + s1.z, bfhi(x.w) + s1.w);
        *(GAS v4u*)(((bf16*)(F.ws + WS_HB)) + off) = o;
    } else {
        const v4u h = *(const GAS v4u*)(((const bf16*)(F.ws + WS_HB)) + off), e = *(const GAS v4u*)(((const bf16*)(F.ws + WS_ERAW)) + off);
        const float re = ((const float*)(F.ws + WS_RSTDE))[row]; const float* gp = inp(17) + oc0; const f32x4 g0 = *(const f32x4*)gp, g1 = *(const f32x4*)(gp + 4);
        f32x4 y0, y1;
        y0.x = bflo(h.x) + fast_sigmoid(s0.x) * (bflo(e.x) * re * g0.x); y0.y = bfhi(h.x) + fast_sigmoid(s0.y) * (bfhi(e.x) * re * g0.y); y0.z = bflo(h.y) + fast_sigmoid(s0.z) * (bflo(e.y) * re * g0.z); y0.w = bfhi(h.y) + fast_sigmoid(s0.w) * (bfhi(e.y) * re * g0.w);
        y1.x = bflo(h.z) + fast_sigmoid(s1.x) * (bflo(e.z) * re * g1.x); y1.y = bfhi(h.z) + fast_sigmoid(s1.y) * (bfhi(e.z) * re * g1.y); y1.z = bflo(h.w) + fast_sigmoid(s1.z) * (bflo(e.w) * re * g1.z); y1.w = bfhi(h.w) + fast_sigmoid(s1.w) * (bfhi(e.w) * re * g1.w);
        float* yo = F.out + OUT_Y + off; *(f32x4*)yo = y0; *(f32x4*)(yo + 4) = y1;
    }
    __syncthreads();
}

struct Args { const float* in[19]; float* out; unsigned char* ws; int ph_lo, ph_hi, qlo, qhi; };
__global__ void __launch_bounds__(NWAVES * 64, 2) hymba_fwd(Args args) {
    extern __shared__ __attribute__((aligned(16))) unsigned char lds[];
    Frame F;
    F.lds = (LAS unsigned char*)lds;
    F.MISC = (volatile LAS unsigned*)(F.lds + MISC_OFF);
    F.wave = __builtin_amdgcn_readfirstlane((int)threadIdx.x >> 6);
    F.G = gridDim.x; { const int bx = blockIdx.x; F.vcu = (F.G % 8 == 0) ? (bx % 8) * (F.G / 8) + bx / 8 : bx; }
    unsigned char* ws = args.ws;
    F.ctl = (gu32*)(ws + WS_CTL); F.ws = ws;
    F.out = args.out;
    for (int u = (int)threadIdx.x; u < (LDS_BYTES - LDSCTL_OFF) / 4; u += NWAVES * 64) ((LAS unsigned*)(F.lds + LDSCTL_OFF))[u] = 0u;
    __syncthreads();
    XcdBarrier bar; bar.wave = F.wave; bar.bar = (unsigned*)(F.ctl + CW_BAR); bar.x = 0; bar.st = nullptr;
    if (N_LAUNCHES != PER_PHASE) bar = xcd_barrier_post((unsigned*)(F.ctl + CW_BAR), F.MISC + 8);
#define GRID_BAR(seam) do { if (N_LAUNCHES == PER_PHASE) { if (F.wave == 0 && lane_id() == 0) __hip_atomic_store(F.ctl + CW_TMO, 0xBADBA0u | (unsigned)(seam), RLX_AGENT); } else { xcd_barrier(bar); } } while (0)
    const int lo = args.ph_lo, hi = args.ph_hi;
#define IN(k) (lo <= (k) && (k) < hi)
#define BOTH(k) (IN(k) && IN((k) + 1))
    const int gw = F.vcu * NWAVES + F.wave, NGW = F.G * NWAVES;

    if (IN(0)) { p0_prologue(F); if (BOTH(0)) GRID_BAR(0); }

    if (IN(1)) {
        { pg8::Gemm g{((bf16*)(F.ws + WS_XB)), ((bf16*)(F.ws + WS_WIN)), M, DIN, D}; pg8::StaticOrder S; S.init(M, DIN, F.G, (int)blockIdx.x);
          pg8::EpiInProj E{((float*)(F.ws + WS_RSTD)), ((bf16*)(F.ws + WS_SEG)), SEG_BYTES / 2, F.out + OUT_KWIN, F.out + OUT_VWIN, F.out + OUT_KNEW, F.out + OUT_VNEW, inp(12), inp(13), MP, F.lds + pg8::STG_OFF};
          pg8::gemm_phase<pg8::EpiInProj, pg8::StaticOrder, true, true>(F.lds + RING_OFF, g, S, E, F.wave); }
        { int kple = DPLE; asm volatile("" : "+s"(kple));
          pg8::Gemm g{((bf16*)(F.ws + WS_PB)), ((bf16*)(F.ws + WS_WPLE)), M, D, kple}; pg8::FillOrder S; S.init(M, D, F.G, (int)blockIdx.x, (M / 256) * (DIN / 256));
          pg8::EpiPle E{((bf16*)(F.ws + WS_ERAW)), ((float*)(F.ws + WS_ESS)), F.lds + pg8::STG_OFF};
          pg8::gemm_phase<pg8::EpiPle, pg8::FillOrder, true, true>(F.lds + RING_OFF, g, S, E, F.wave); }
        if (BOTH(1)) GRID_BAR(1);
    }

    if (IN(2)) {
        for (int m = gw * 64 + lane_id(); m < M; m += NGW * 64) { const f32x4* e = (const f32x4*)(((float*)(F.ws + WS_ESS)) + (size_t)m * 16); const f32x4 a = e[0], b = e[1], c = e[2], d = e[3];
            const float ss = ((a.x + a.y) + (a.z + a.w)) + ((b.x + b.y) + (b.z + b.w)) + ((c.x + c.y) + (c.z + c.w)) + ((d.x + d.y) + (d.z + d.w));
            ((float*)(F.ws + WS_RSTDE))[m] = 1.0f / sqrtf(ss * (1.0f / D) + RMS_EPS); }
        constexpr int NU_S = NBS, NU_T = NBP * NH * 6, NU_G = MP / 128, NU_g = NBS * NGRP / NWAVES, NU = NU_S + NU_T + NU_G + NU_g;
        unsigned tk = 0u; const bool t0 = (F.wave == 0) && (lane_id() == 0);
        if (t0) tk = __hip_atomic_fetch_add(F.ctl + CW_QHEAD, 1u, RLX_AGENT);
        for (;;) {
            __syncthreads();
            if (t0) F.MISC[16] = tk;
            __syncthreads();
            int u = (int)F.MISC[16] + args.qlo;
            if (u >= NU || u >= args.qhi) break;
            if (t0) tk = __hip_atomic_fetch_add(F.ctl + CW_QHEAD, 1u, RLX_AGENT);
            if (u < NU_S) { samp_unit(F, u); continue; } u -= NU_S;
            if (u < NU_T) { const int type = u >> 8, rem = u & 255, bh = rem & 127; tj_unit(F, bh >> 3, bh & 7, type, rem >> 7); continue; } u -= NU_T;
            if (u < NU_G) { gmlp_batch(F, u * 128); continue; } u -= NU_G;
            { const int task = u * NWAVES + F.wave; gmlp_sample_task(F, task >> 2, task & 3); }
        }
        if (BOTH(2)) GRID_BAR(2);
    }

    if (IN(3)) {
        { const int lane = lane_id(); for (int m = gw; m < MP; m += NGW) attn_finish_row(F, (size_t)m, lane); }
        if (BOTH(3)) GRID_BAR(3);
    }

    if (IN(4)) {
        const bool tile_first = (blockIdx.x & 1) == 0;
        for (int pass = 0; pass < 2; ++pass) {
            if ((pass == 0) == tile_first) { for (int t = F.vcu; t < 256; t += F.G) small_tile<0>(F, t, (const bf16*)(F.ws + WS_MIX), (const bf16*)(F.ws + WS_WOUT)); }
            else { pg8::Gemm g{((bf16*)(F.ws + WS_MIX)), ((bf16*)(F.ws + WS_WOUT)), MP, D, D}; pg8::StaticOrder S; S.init(MP, D, F.G, (int)blockIdx.x);
                pg8::EpiOut E{((bf16*)(F.ws + WS_XB)), ((bf16*)(F.ws + WS_HB)), F.lds + pg8::STG_OFF};
                pg8::gemm_phase<pg8::EpiOut, pg8::StaticOrder, true, true>(F.lds + RING_OFF, g, S, E, F.wave); }
        }
        if (BOTH(4)) GRID_BAR(4);
    }

    if (IN(5)) {
        const bool tile_first = (blockIdx.x & 1) == 0;
        for (int pass = 0; pass < 2; ++pass) {
            if ((pass == 0) == tile_first) { for (int t = F.vcu; t < 256; t += F.G) small_tile<1>(F, t, (const bf16*)(F.ws + WS_HB), (const bf16*)(F.ws + WS_WG)); }
            else { pg8::Gemm g{((bf16*)(F.ws + WS_HB)), ((bf16*)(F.ws + WS_WG)), MP, D, D}; pg8::StaticOrder S; S.init(MP, D, F.G, (int)blockIdx.x);
                pg8::EpiGate E{F.out + OUT_Y, ((bf16*)(F.ws + WS_HB)), ((bf16*)(F.ws + WS_ERAW)), ((float*)(F.ws + WS_RSTDE)), inp(17), F.lds + pg8::STG_OFF};
                pg8::gemm_phase<pg8::EpiGate, pg8::StaticOrder, true, true>(F.lds + RING_OFF, g, S, E, F.wave); }
        }
    }
#undef IN
#undef BOTH
#undef GRID_BAR
}

extern "C" void kernel_launch(void* const* d_in, const int* in_sizes, int n_in, void* d_out, int out_size, void* d_ws, size_t ws_size, hipStream_t stream) {
    static int grid = 0;
    if (grid == 0) {
        if (n_in != 19 || in_sizes[0] != MP * D || (size_t)out_size != OUT_END || ws_size < WS_END) { fprintf(stderr, "kernel_launch: unexpected shapes (n_in %d, in0 %d, out %d, ws %zu); nothing launched\n", n_in, n_in > 0 ? in_sizes[0] : -1, out_size, ws_size); grid = -1; return; }
        int dev = 0, cus = 0, per_cu = 0;
        if (hipGetDevice(&dev) != hipSuccess || hipDeviceGetAttribute(&cus, hipDeviceAttributeMultiprocessorCount, dev) != hipSuccess) { fprintf(stderr, "kernel_launch: device query failed\n"); grid = -1; return; }
        if (hipFuncSetAttribute((const void*)hymba_fwd, hipFuncAttributeMaxDynamicSharedMemorySize, LDS_BYTES) != hipSuccess) { fprintf(stderr, "kernel_launch: hipFuncSetAttribute failed\n"); grid = -1; return; }
        if (hipOccupancyMaxActiveBlocksPerMultiprocessor(&per_cu, (const void*)hymba_fwd, NWAVES * 64, LDS_BYTES) != hipSuccess || per_cu < 1)
            fprintf(stderr, "kernel_launch: note: occupancy query reports %d workgroups per CU\n", per_cu);
        (void)hipGetLastError();
        grid = cus;
    }
    if (grid < 0) return;
    if (hipMemsetAsync((char*)d_ws + WS_CTL, 0, CTL_ZERO_BYTES, stream) != hipSuccess) { fprintf(stderr, "kernel_launch: memset failed\n"); return; }
    Args a{};
    for (int i = 0; i < 19; ++i) a.in[i] = (const float*)d_in[i];
    a.out = (float*)d_out; a.ws = (unsigned char*)d_ws;
    static_assert(N_LAUNCHES == 1 || N_LAUNCHES == PER_PHASE, "MK_N_LAUNCHES is 1 or 6");
#ifndef PROBE_DUP
#define PROBE_DUP -1
#endif
#ifndef PROBE_QLO
#define PROBE_QLO 0
#endif
#ifndef PROBE_QHI
#define PROBE_QHI (1 << 30)
#endif
    for (int li = 0; li < N_LAUNCHES; ++li) {
        a.ph_lo = (N_LAUNCHES == PER_PHASE) ? li : 0; a.ph_hi = (N_LAUNCHES == PER_PHASE) ? li + 1 : PER_PHASE; a.qlo = 0; a.qhi = 1 << 30;
        const int reps = (N_LAUNCHES == PER_PHASE && PROBE_DUP == li && li < 4) ? 2 : 1;
        for (int rp = 0; rp < reps; ++rp) {
            if (rp == 1 && li == 2) { (void)hipMemsetAsync((char*)d_ws + WS_CTL + 4 * CW_QHEAD, 0, 16, stream); a.qlo = PROBE_QLO; a.qhi = PROBE_QHI; }
            hipLaunchKernelGGL(hymba_fwd, dim3(grid), dim3(NWAVES * 64), LDS_BYTES, stream, a);
            const hipError_t le = hipPeekAtLastError();
            if (le != hipSuccess) { fprintf(stderr, "kernel_launch: launch %d failed: %s\n", li, hipGetErrorName(le)); break; }
        }
    }
    if (N_LAUNCHES == PER_PHASE && PROBE_DUP == 4) for (int li = 4; li < 6; ++li) { a.ph_lo = li; a.ph_hi = li + 1; hipLaunchKernelGGL(hymba_fwd, dim3(grid), dim3(NWAVES * 64), LDS_BYTES, stream, a); }
}
```

```cpp
#include <hip/hip_runtime.h>
#include <cstdio>
#include <cstdint>
#ifndef MK_N_LAUNCHES
#define MK_N_LAUNCHES 1
#endif
namespace pg8 {
#define PG8_LAS __attribute__((address_space(3)))
typedef unsigned short bf16_t;
typedef short bf16x8 __attribute__((ext_vector_type(8)));
typedef float f32x4 __attribute__((ext_vector_type(4)));
typedef unsigned u32x4 __attribute__((ext_vector_type(4)));
constexpr int BM = 256, BK = 64, HALF = 128, HTB = HALF * BK * 2  , STAGE_BYTES = 8 * HTB, NXCD = 8, WGM = 8;

__host__ __device__ __forceinline__ int lds_byte(int r, int c) { const int st = (r >> 4) * 2 + (c >> 5), rr = r & 15, cc = c & 31, ob = rr * 64 + cc * 2; return st * 1024 + (ob ^ (((ob >> 9) & 1) << 5)); }
__host__ __device__ __forceinline__ void stage_rc(int b, int& R, int& C) { const int st = b / 1024, sb = b % 1024, swz = sb ^ (((sb >> 9) & 1) << 5); R = (st >> 1) * 16 + swz / 64; C = (st & 1) * 32 + (swz % 64) / 2; }
__host__ __device__ __forceinline__ int perm32(int rho) { const int n = rho >> 4, i = rho & 15; return 8 * (i >> 2) + 4 * n + (i & 3); }

struct Unit { int pm, pn; };
struct Gemm { const bf16_t* A; const bf16_t* Bt; int M, N, K; };

struct StaticOrder {
    int nM, nN, nwg, G, c;
    __host__ __device__ void init(int M, int N, int G_, int c_) { nM = M / BM; nN = N / BM; nwg = nM * nN; G = G_; c = c_; }
    __host__ __device__ bool next(int i, Unit& u) const {
        const long L = (long)i * G + c; if (L >= nwg) return false;
        int wgid = (int)L; { const int q = nwg / NXCD, r = nwg % NXCD, xcd = wgid % NXCD, off = wgid / NXCD; wgid = (xcd < r ? xcd * (q + 1) : r * (q + 1) + (xcd - r) * q) + off; }
        const int nig = WGM * nN, gid = wgid / nig, fm = gid * WGM, gsz = (nM - fm) < WGM ? (nM - fm) : WGM;
        u.pm = fm + ((wgid % nig) % gsz); u.pn = (wgid % nig) / gsz; return true;
    }
    __device__ __forceinline__ void a_ready(const Unit&) const {}
    __device__ __forceinline__ void done(const Unit&) const {}
};
template <class Epi, class Sched, bool ALIGN_EPI = false, bool SP2 = false>
__device__ __forceinline__ void gemm_phase(PG8_LAS unsigned char* lds, const Gemm g, const Sched& S, const Epi& E, const int wid  ) {
    const int lane = (int)__builtin_amdgcn_mbcnt_hi(~0u, __builtin_amdgcn_mbcnt_lo(~0u, 0u)), tid = wid * 64 + lane, wr = wid >> 2, wc = wid & 3, fr = lane & 15, fq = lane >> 4;
    const int K = g.K, nt = K / BK;
    unsigned voffA[2], voffB[2];
#pragma unroll
    for (int i = 0; i < 2; ++i) { int R, C; stage_rc(tid * 16 + i * 8192, R, C); const int Rb = Epi::PERM ? ((R & ~31) + perm32(R & 31)) : R;
        voffA[i] = (unsigned)(R * K + C) * 2u; voffB[i] = (unsigned)(Rb * K + C) * 2u; }
    const size_t kstep = (size_t)(BK * 2);
    const size_t hstep = (size_t)HALF * K * 2;
    const size_t tstep = 2 * hstep;
    const unsigned ldsw = (unsigned)wid * 1024u;
    const int aoff = lds_byte(wr * 64 + fr, fq * 8), boff = lds_byte(wc * 32 + fr, fq * 8);
#define PG8_SA(b, h) (((b) * 2 + (h)) * HTB)
#define PG8_SB(b, h) ((4 + (b) * 2 + (h)) * HTB)
#define PG8_STAGE(bufoff, gbase, voff) do { _Pragma("unroll") for (int _i = 0; _i < 2; ++_i) \
        __builtin_amdgcn_global_load_lds((const unsigned*)((const char*)(gbase) + (voff)[_i]), (PG8_LAS unsigned*)(lds + (bufoff) + ldsw + _i * 8192), 16, 0, 0); } while (0)
#define PG8_LDA(dst, b, h) do { _Pragma("unroll") for (int m = 0; m < 4; ++m) _Pragma("unroll") for (int k = 0; k < 2; ++k) dst[m][k] = *(const PG8_LAS bf16x8*)(lds + PG8_SA(b, h) + aoff + m * 2048 + k * 1024); } while (0)
#define PG8_LDB(dst, b, h) do { _Pragma("unroll") for (int n = 0; n < 2; ++n) _Pragma("unroll") for (int k = 0; k < 2; ++k) dst[n][k] = *(const PG8_LAS bf16x8*)(lds + PG8_SB(b, h) + boff + n * 2048 + k * 1024); } while (0)
#define PG8_MMA(ai, bj, At, Bt) do { __builtin_amdgcn_s_setprio(1); _Pragma("unroll") for (int m = 0; m < 4; ++m) _Pragma("unroll") for (int n = 0; n < 2; ++n) _Pragma("unroll") for (int k = 0; k < 2; ++k) \
        acc[ai][bj][m][n] = __builtin_amdgcn_mfma_f32_16x16x32_bf16(Bt[n][k], At[m][k], acc[ai][bj][m][n], 0, 0, 0); __builtin_amdgcn_s_setprio(0); } while (0)
#define PG8_WAIT_V(n) asm volatile("s_waitcnt vmcnt(" #n ")" ::: "memory")
#define PG8_WAIT_L(n) asm volatile("s_waitcnt lgkmcnt(" #n ")" ::: "memory")
#define PG8_BAR __builtin_amdgcn_s_barrier()
#define PG8_SCHED __builtin_amdgcn_sched_barrier(0)
    Unit cur, nxt; int ui = 0;
    if (!S.next(0, cur)) return;
    f32x4 acc[2][2][4][2];
#pragma unroll
    for (int a = 0; a < 2; ++a)
#pragma unroll
        for (int b = 0; b < 2; ++b)
#pragma unroll
            for (int m = 0; m < 4; ++m)
#pragma unroll
                for (int n = 0; n < 2; ++n) acc[a][b][m][n] = (f32x4){0.f, 0.f, 0.f, 0.f};
    bf16x8 At[4][2], B0[2][2], B1[2][2];
    const char* cA = (const char*)g.A + (size_t)cur.pm * tstep; const char* cB = (const char*)g.Bt + (size_t)cur.pn * tstep;
    S.a_ready(cur);
    if constexpr (SP2) {
        PG8_STAGE(PG8_SB(0, 0), cB, voffB); PG8_STAGE(PG8_SB(0, 1), cB + hstep, voffB); PG8_STAGE(PG8_SA(0, 0), cA, voffA); PG8_STAGE(PG8_SA(0, 1), cA + hstep, voffA);
        if (wr == 1) PG8_BAR;
        PG8_WAIT_V(2); PG8_BAR;
        PG8_STAGE(PG8_SB(1, 0), cB + kstep, voffB); PG8_STAGE(PG8_SA(1, 0), cA + kstep, voffA); PG8_STAGE(PG8_SB(1, 1), cB + hstep + kstep, voffB);
        PG8_WAIT_V(6); PG8_BAR;
    } else {
        PG8_STAGE(PG8_SB(0, 0), cB, voffB); PG8_STAGE(PG8_SA(0, 0), cA, voffA); PG8_STAGE(PG8_SB(0, 1), cB + hstep, voffB); PG8_STAGE(PG8_SA(0, 1), cA + hstep, voffA);
        if (wr == 1) PG8_BAR;
        PG8_WAIT_V(4); PG8_BAR;
        PG8_STAGE(PG8_SB(1, 0), cB + kstep, voffB); PG8_STAGE(PG8_SA(1, 0), cA + kstep, voffA); PG8_STAGE(PG8_SB(1, 1), cB + hstep + kstep, voffB);
        PG8_WAIT_V(6); PG8_BAR;
    }
    for (;;) {
        const bool has_next = S.next(ui + 1, nxt);
        const char* nA = has_next ? (const char*)g.A + (size_t)nxt.pm * tstep : cA; const char* nB = has_next ? (const char*)g.Bt + (size_t)nxt.pn * tstep : cB;
        for (int t = 0; t < nt; t += 2) {
            const bool last = (t == nt - 2);
            const char* a1 = cA + (size_t)(t + 1) * kstep;
            const char* a2 = last ? nA : cA + (size_t)(t + 2) * kstep; const char* b2 = last ? nB : cB + (size_t)(t + 2) * kstep;
            const char* a3 = a2 + kstep; const char* b3 = b2 + kstep;
            if (last && has_next) S.a_ready(nxt);
            if constexpr (SP2) {
            PG8_LDB(B0, 0, 0); PG8_LDB(B1, 0, 1); PG8_SCHED; PG8_LDA(At, 0, 0); PG8_STAGE(PG8_SA(1, 1), a1 + hstep, voffA);
            PG8_WAIT_V(8); PG8_WAIT_L(0); PG8_BAR; PG8_MMA(0, 0, At, B0); PG8_MMA(0, 1, At, B1); PG8_BAR; PG8_SCHED;
            PG8_LDA(At, 0, 1); PG8_STAGE(PG8_SB(0, 0), b2, voffB); PG8_STAGE(PG8_SB(0, 1), b2 + hstep, voffB); PG8_STAGE(PG8_SA(0, 0), a2, voffA);
            PG8_WAIT_V(8); PG8_WAIT_L(0); PG8_BAR; PG8_MMA(1, 0, At, B0); PG8_MMA(1, 1, At, B1); PG8_BAR; PG8_SCHED;
            PG8_LDB(B0, 1, 0); PG8_LDB(B1, 1, 1); PG8_SCHED; PG8_LDA(At, 1, 0); PG8_STAGE(PG8_SA(0, 1), a2 + hstep, voffA);
            PG8_WAIT_V(8); PG8_WAIT_L(0); PG8_BAR; PG8_MMA(0, 0, At, B0); PG8_MMA(0, 1, At, B1); PG8_BAR; PG8_SCHED;
            PG8_LDA(At, 1, 1); PG8_STAGE(PG8_SB(1, 0), b3, voffB); PG8_STAGE(PG8_SB(1, 1), b3 + hstep, voffB); PG8_STAGE(PG8_SA(1, 0), a3, voffA);
            PG8_WAIT_V(8); PG8_WAIT_L(0); PG8_BAR; PG8_MMA(1, 0, At, B0); PG8_MMA(1, 1, At, B1); PG8_BAR; PG8_SCHED;
            } else {
            PG8_LDB(B0, 0, 0); PG8_SCHED; PG8_LDA(At, 0, 0); PG8_STAGE(PG8_SA(1, 1), a1 + hstep, voffA);
            PG8_WAIT_L(8); PG8_BAR; PG8_WAIT_L(0); PG8_MMA(0, 0, At, B0); PG8_BAR; PG8_SCHED;
            PG8_LDB(B1, 0, 1); PG8_STAGE(PG8_SB(0, 0), b2, voffB);
            PG8_BAR; PG8_WAIT_L(0); PG8_MMA(0, 1, At, B1); PG8_BAR;
            PG8_LDA(At, 0, 1); PG8_STAGE(PG8_SA(0, 0), a2, voffA);
            PG8_BAR; PG8_WAIT_L(0); PG8_MMA(1, 0, At, B0); PG8_BAR; PG8_SCHED;
            PG8_STAGE(PG8_SB(0, 1), b2 + hstep, voffB);
            PG8_WAIT_V(6); PG8_BAR; PG8_MMA(1, 1, At, B1); PG8_BAR;
            PG8_LDB(B0, 1, 0); PG8_SCHED; PG8_LDA(At, 1, 0); PG8_STAGE(PG8_SA(0, 1), a2 + hstep, voffA);
            PG8_WAIT_L(8); PG8_BAR; PG8_WAIT_L(0); PG8_MMA(0, 0, At, B0); PG8_BAR; PG8_SCHED;
            PG8_LDB(B1, 1, 1); PG8_STAGE(PG8_SB(1, 0), b3, voffB);
            PG8_BAR; PG8_WAIT_L(0); PG8_MMA(0, 1, At, B1); PG8_BAR;
            PG8_LDA(At, 1, 1); PG8_STAGE(PG8_SA(1, 0), a3, voffA);
            PG8_BAR; PG8_WAIT_L(0); PG8_MMA(1, 0, At, B0); PG8_BAR; PG8_SCHED;
            PG8_STAGE(PG8_SB(1, 1), b3 + hstep, voffB);
            PG8_WAIT_V(6); PG8_BAR; PG8_MMA(1, 1, At, B1); PG8_BAR;
            }
        }
        if constexpr (ALIGN_EPI) { if (wr == 0) PG8_BAR; }
        if constexpr (!Epi::AFTER_DRAIN) { E(acc, cur, wr, wc, fr, fq); S.done(cur); }
        if (!has_next) break;
#pragma unroll
        for (int a = 0; a < 2; ++a)
#pragma unroll
            for (int b = 0; b < 2; ++b)
#pragma unroll
                for (int m = 0; m < 4; ++m)
#pragma unroll
                    for (int n = 0; n < 2; ++n) acc[a][b][m][n] = (f32x4){0.f, 0.f, 0.f, 0.f};
        cur = nxt; cA = nA; cB = nB; ++ui;
        if constexpr (ALIGN_EPI) { if (wr == 1) PG8_BAR; }
    }
    PG8_WAIT_V(0);
    if constexpr (!ALIGN_EPI) { if (wr == 0) PG8_BAR; }
    PG8_BAR;
    if constexpr (Epi::AFTER_DRAIN) { E.fused(acc, cur, wr, wc, fr, fq, lds, wid, lane); S.done(cur); }
#undef PG8_SA
#undef PG8_SB
#undef PG8_STAGE
#undef PG8_LDA
#undef PG8_LDB
#undef PG8_MMA
#undef PG8_WAIT_V
#undef PG8_WAIT_L
#undef PG8_BAR
#undef PG8_SCHED
}
}
namespace pg8 {
typedef float f32x2_t __attribute__((ext_vector_type(2)));
typedef __bf16 bf16x2_t __attribute__((ext_vector_type(2)));
typedef unsigned u32x2 __attribute__((ext_vector_type(2)));
__device__ __forceinline__ unsigned pk2(float lo, float hi) { f32x2_t v = {lo, hi}; bf16x2_t b = __builtin_convertvector(v, bf16x2_t); return __builtin_bit_cast(unsigned, b); }
__device__ __forceinline__ float bflo(unsigned u) { return __uint_as_float(u << 16); }
__device__ __forceinline__ float bfhi(unsigned u) { return __uint_as_float(u & 0xffff0000u); }
__device__ __forceinline__ float fast_sigmoid(float v) { return __builtin_amdgcn_rcpf(1.0f + __builtin_amdgcn_exp2f(-1.4426950408889634f * v)); }
constexpr float RMS_EPS = 1e-6f;
constexpr float QSCALE = 0.125f * 1.4426950408889634f;

constexpr int STG_OFF = 131072, STG_WAVE = 16 * 144;
template <bool NT = true> __device__ __forceinline__ void stage_store_128(PG8_LAS unsigned char* sw, int fr, int lane, int o0, const u32x4 v0, int o1, const u32x4 v1, unsigned char* g0, size_t pitch) {
    *(PG8_LAS u32x4*)(sw + fr * 144 + o0) = v0; *(PG8_LAS u32x4*)(sw + fr * 144 + o1) = v1;
#pragma unroll
    for (int i = 0; i < 2; ++i) { const int row = 8 * i + (lane >> 3), ch = lane & 7; const u32x4 t = *(const PG8_LAS u32x4*)(sw + row * 144 + 16 * ch); if (NT) __builtin_nontemporal_store(t, (u32x4*)(g0 + (size_t)row * pitch + 16 * ch)); else *(u32x4*)(g0 + (size_t)row * pitch + 16 * ch) = t; }
}
struct EpiInProj {
    static constexpr bool PERM = true, AFTER_DRAIN = false;
    const float* rstd; bf16_t* seg0; size_t seg_stride; float *kwin, *vwin, *knew, *vnew; const float *gq, *gk; int mp; PG8_LAS unsigned char* stg;
    __device__ __forceinline__ void operator()(const f32x4 (&acc)[2][2][4][2], const Unit& u, int wr, int wc, int fr, int fq) const {
        asm volatile("" : "+v"(fr), "+v"(fq));
        const int sg = u.pn >> 1;
        const int col0 = (u.pn & 1) * 256 + wc * 64 + 8 * fq;
        const int row0 = u.pm * BM + wr * 64 + fr;
        bf16_t* ob = seg0 + (size_t)sg * seg_stride;
        const bool prompt = row0 < mp;
        float* fo = nullptr;
        if (sg == 4) fo = prompt ? kwin : knew;
        if (sg == 5) fo = prompt ? vwin : vnew;
        const int frow0 = prompt ? row0 : row0 - mp;
        const bool do_norm = (sg == 3) || (sg == 4), do_silu = (sg == 2) || (sg == 6);
        f32x4 gn[2][2];
#pragma unroll
        for (int bj = 0; bj < 2; ++bj)
#pragma unroll
            for (int n = 0; n < 2; ++n) gn[bj][n] = (f32x4){1.f, 1.f, 1.f, 1.f};
        if (do_norm) { const float* g = (sg == 3) ? gq : gk; const float sc = (sg == 3) ? QSCALE : 1.0f;
#pragma unroll
            for (int bj = 0; bj < 2; ++bj)
#pragma unroll
                for (int n = 0; n < 2; ++n) gn[bj][n] = *(const f32x4*)(g + 32 * bj + 8 * fq + 4 * n) * sc; }
        float rsv[2][4];
#pragma unroll
        for (int m = 0; m < 4; ++m) rsv[0][m] = rstd[row0 + m * 16];
#pragma unroll
        for (int ai = 0; ai < 2; ++ai) {
#pragma unroll
            for (int m = 0; m < 4; ++m) {
                if (ai == 0 && m == 1) {
#pragma unroll
                    for (int mm = 0; mm < 4; ++mm) rsv[1][mm] = rstd[row0 + HALF + mm * 16];
                }
                const int r = row0 + ai * HALF + m * 16;
                const float rs = rsv[ai][m];
                f32x4 v[2][2];
#pragma unroll
                for (int bj = 0; bj < 2; ++bj)
#pragma unroll
                    for (int n = 0; n < 2; ++n) v[bj][n] = acc[ai][bj][m][n] * rs;
                if (do_norm) {
                    float ss = 0.f;
#pragma unroll
                    for (int bj = 0; bj < 2; ++bj)
#pragma unroll
                        for (int n = 0; n < 2; ++n) { const f32x4 x = v[bj][n]; ss += (x[0] * x[0] + x[1] * x[1]) + (x[2] * x[2] + x[3] * x[3]); }
                    ss += __shfl_xor(ss, 16); ss += __shfl_xor(ss, 32);
                    const float rn = 1.0f / sqrtf(ss * (1.0f / 64.0f) + RMS_EPS);
#pragma unroll
                    for (int bj = 0; bj < 2; ++bj)
#pragma unroll
                        for (int n = 0; n < 2; ++n) v[bj][n] = v[bj][n] * rn * gn[bj][n];
                }
                if (do_silu) {
#pragma unroll
                    for (int bj = 0; bj < 2; ++bj)
#pragma unroll
                        for (int n = 0; n < 2; ++n)
#pragma unroll
                            for (int j = 0; j < 4; ++j) v[bj][n][j] = v[bj][n][j] * fast_sigmoid(v[bj][n][j]);
                }
                const int lane_ = fr + 16 * fq; PG8_LAS unsigned char* sw = stg + (wr * 4 + wc) * STG_WAVE;
                const int rb = u.pm * BM + wr * 64 + ai * HALF + m * 16, cb = (u.pn & 1) * 256 + wc * 64;
                { u32x4 w0, w1; w0.x = pk2(v[0][0][0], v[0][0][1]); w0.y = pk2(v[0][0][2], v[0][0][3]); w0.z = pk2(v[0][1][0], v[0][1][1]); w0.w = pk2(v[0][1][2], v[0][1][3]);
                  w1.x = pk2(v[1][0][0], v[1][0][1]); w1.y = pk2(v[1][0][2], v[1][0][3]); w1.z = pk2(v[1][1][0], v[1][1][1]); w1.w = pk2(v[1][1][2], v[1][1][3]);
                  if (sg >= 3 && sg <= 5) stage_store_128<false>(sw, fr, lane_, 16 * fq, w0, 64 + 16 * fq, w1, (unsigned char*)(ob + (size_t)rb * 512 + cb), 1024);
                  else stage_store_128<true>(sw, fr, lane_, 16 * fq, w0, 64 + 16 * fq, w1, (unsigned char*)(ob + (size_t)rb * 512 + cb), 1024); }
                if (fo) { float* f0 = fo + (size_t)(prompt ? rb : rb - mp) * 512 + cb;
#pragma unroll
                    for (int bj = 0; bj < 2; ++bj) stage_store_128(sw, fr, lane_, 32 * fq, __builtin_bit_cast(u32x4, v[bj][0]), 32 * fq + 16, __builtin_bit_cast(u32x4, v[bj][1]), (unsigned char*)(f0 + 32 * bj), 2048); }
            }
        }
    }
};
struct EpiPle {
    static constexpr bool PERM = true, AFTER_DRAIN = false;
    bf16_t* eraw; float* ess; PG8_LAS unsigned char* stg;
    __device__ __forceinline__ void operator()(const f32x4 (&acc)[2][2][4][2], const Unit& u, int wr, int wc, int fr, int fq) const {
        asm volatile("" : "+v"(fr), "+v"(fq));
        const int lane_ = fr + 16 * fq; PG8_LAS unsigned char* sw = stg + (wr * 4 + wc) * STG_WAVE;
        const int cb = u.pn * BM + wc * 64;
#pragma unroll
        for (int ai = 0; ai < 2; ++ai)
#pragma unroll
            for (int m = 0; m < 4; ++m) {
                const int rb = u.pm * BM + wr * 64 + ai * HALF + m * 16; float ss = 0.f; u32x4 w[2];
#pragma unroll
                for (int bj = 0; bj < 2; ++bj) { const f32x4 a = acc[ai][bj][m][0], b = acc[ai][bj][m][1];
                    ss += (a[0] * a[0] + a[1] * a[1]) + (a[2] * a[2] + a[3] * a[3]); ss += (b[0] * b[0] + b[1] * b[1]) + (b[2] * b[2] + b[3] * b[3]);
                    w[bj].x = pk2(a[0], a[1]); w[bj].y = pk2(a[2], a[3]); w[bj].z = pk2(b[0], b[1]); w[bj].w = pk2(b[2], b[3]); }
                stage_store_128(sw, fr, lane_, 16 * fq, w[0], 64 + 16 * fq, w[1], (unsigned char*)(eraw + (size_t)rb * 1024 + cb), 2048);
                ss += __shfl_xor(ss, 16); ss += __shfl_xor(ss, 32);
                if (fq == 0) ess[(size_t)(rb + fr) * 16 + u.pn * 4 + wc] = ss;
            }
    }
};
struct EpiOut {
    static constexpr bool PERM = true, AFTER_DRAIN = false;
    const bf16_t* xb; bf16_t* hb; PG8_LAS unsigned char* stg;
    __device__ __forceinline__ void operator()(const f32x4 (&acc)[2][2][4][2], const Unit& u, int wr, int wc, int fr, int fq) const {
        asm volatile("" : "+v"(fr), "+v"(fq));
        const int lane_ = fr + 16 * fq; PG8_LAS unsigned char* sw = stg + (wr * 4 + wc) * STG_WAVE;
        const int cb = u.pn * BM + wc * 64;
        constexpr int PD = 3;
        u32x4 xq[8][2];
#pragma unroll
        for (int it = 0; it < PD; ++it)
#pragma unroll
            for (int bj = 0; bj < 2; ++bj) xq[it][bj] = __builtin_nontemporal_load((const u32x4*)(xb + (size_t)(u.pm * BM + wr * 64 + (it >> 2) * HALF + (it & 3) * 16 + fr) * 1024 + cb + 8 * fq + 32 * bj));
#pragma unroll
        for (int it = 0; it < 8; ++it) {
            const int ai = it >> 2, m = it & 3;
            if (it + PD < 8) {
#pragma unroll
                for (int bj = 0; bj < 2; ++bj) xq[(it + PD) & 7][bj] = __builtin_nontemporal_load((const u32x4*)(xb + (size_t)(u.pm * BM + wr * 64 + ((it + PD) >> 2) * HALF + ((it + PD) & 3) * 16 + fr) * 1024 + cb + 8 * fq + 32 * bj));
            }
            const int rb = u.pm * BM + wr * 64 + ai * HALF + m * 16;
            u32x4 w[2];
#pragma unroll
            for (int bj = 0; bj < 2; ++bj) { const f32x4 a = acc[ai][bj][m][0], b = acc[ai][bj][m][1]; const u32x4 x = xq[it][bj];
                w[bj].x = pk2(bflo(x.x) + a[0], bfhi(x.x) + a[1]); w[bj].y = pk2(bflo(x.y) + a[2], bfhi(x.y) + a[3]); w[bj].z = pk2(bflo(x.z) + b[0], bfhi(x.z) + b[1]); w[bj].w = pk2(bflo(x.w) + b[2], bfhi(x.w) + b[3]); }
            stage_store_128<false>(sw, fr, lane_, 16 * fq, w[0], 64 + 16 * fq, w[1], (unsigned char*)(hb + (size_t)rb * 1024 + cb), 2048);
        }
    }
};
struct EpiGate {
    static constexpr bool PERM = true, AFTER_DRAIN = false;
    float* y; const bf16_t* hb; const bf16_t* eraw; const float* rstde; const float* gple; PG8_LAS unsigned char* stg;
    __device__ __forceinline__ void operator()(const f32x4 (&acc)[2][2][4][2], const Unit& u, int wr, int wc, int fr, int fq) const {
        asm volatile("" : "+v"(fr), "+v"(fq));
        const int lane_ = fr + 16 * fq; PG8_LAS unsigned char* sw = stg + (wr * 4 + wc) * STG_WAVE;
        const int cb = u.pn * BM + wc * 64;
        f32x4 gp[2][2];
#pragma unroll
        for (int bj = 0; bj < 2; ++bj)
#pragma unroll
            for (int n = 0; n < 2; ++n) gp[bj][n] = *(const f32x4*)(gple + cb + 32 * bj + 8 * fq + 4 * n);
        float rev[2][4];
#pragma unroll
        for (int ai = 0; ai < 2; ++ai)
#pragma unroll
            for (int m = 0; m < 4; ++m) rev[ai][m] = rstde[u.pm * BM + wr * 64 + ai * HALF + m * 16 + fr];
        constexpr int PD = 2;
        u32x4 eq[8][2], hq[8][2];
#pragma unroll
        for (int it = 0; it < PD; ++it)
#pragma unroll
            for (int bj = 0; bj < 2; ++bj) { const size_t o = (size_t)(u.pm * BM + wr * 64 + (it >> 2) * HALF + (it & 3) * 16 + fr) * 1024 + cb + 8 * fq + 32 * bj;
                eq[it][bj] = __builtin_nontemporal_load((const u32x4*)(eraw + o)); hq[it][bj] = *(const u32x4*)(hb + o); }
#pragma unroll
        for (int it = 0; it < 8; ++it) {
            const int ai = it >> 2, m = it & 3;
            if (it + PD < 8) {
#pragma unroll
                for (int bj = 0; bj < 2; ++bj) { const size_t o = (size_t)(u.pm * BM + wr * 64 + ((it + PD) >> 2) * HALF + ((it + PD) & 3) * 16 + fr) * 1024 + cb + 8 * fq + 32 * bj;
                    eq[(it + PD) & 7][bj] = __builtin_nontemporal_load((const u32x4*)(eraw + o)); hq[(it + PD) & 7][bj] = *(const u32x4*)(hb + o); }
            }
            const int rb = u.pm * BM + wr * 64 + ai * HALF + m * 16; const float re = rev[ai][m];
#pragma unroll
            for (int bj = 0; bj < 2; ++bj) {
                const u32x4 e = eq[it][bj], h = hq[it][bj];
                const f32x4 a = acc[ai][bj][m][0], b = acc[ai][bj][m][1];
                const f32x4 e0 = (f32x4){bflo(e.x), bfhi(e.x), bflo(e.y), bfhi(e.y)}, e1 = (f32x4){bflo(e.z), bfhi(e.z), bflo(e.w), bfhi(e.w)};
                const f32x4 h0 = (f32x4){bflo(h.x), bfhi(h.x), bflo(h.y), bfhi(h.y)}, h1 = (f32x4){bflo(h.z), bfhi(h.z), bflo(h.w), bfhi(h.w)};
                f32x4 s0, s1;
#pragma unroll
                for (int j = 0; j < 4; ++j) { s0[j] = fast_sigmoid(a[j]); s1[j] = fast_sigmoid(b[j]); }
                const f32x4 y0 = h0 + s0 * (e0 * re * gp[bj][0]), y1 = h1 + s1 * (e1 * re * gp[bj][1]);
                stage_store_128(sw, fr, lane_, 32 * fq, __builtin_bit_cast(u32x4, y0), 32 * fq + 16, __builtin_bit_cast(u32x4, y1), (unsigned char*)(y + (size_t)rb * 1024 + cb + 32 * bj), 4096); }
        }
    }
};
struct FillOrder {
    int nN, nwg, idx, nfree;
    __host__ __device__ void init(int M, int N, int G, int c, int nprev) { nN = N / BM; nwg = (M / BM) * nN; const int r = nprev % G; if (r == 0) { idx = c; nfree = G; } else { idx = c - r; nfree = G - r; } }
    __host__ __device__ bool next(int i, Unit& u) const { if (idx < 0) return false; const long L = (long)i * nfree + idx; if (L >= nwg) return false; u.pm = (int)(L / nN); u.pn = (int)(L % nN); return true; }
    __device__ __forceinline__ void a_ready(const Unit&) const {}
    __device__ __forceinline__ void done(const Unit&) const {}
};
}
constexpr int NWAVES = 8;
#ifndef MK_N_LAUNCHES
#define MK_N_LAUNCHES 1
#endif
constexpr int N_LAUNCHES = MK_N_LAUNCHES;
constexpr int PER_PHASE = 6;

constexpr int MP = 32768, MS = 1024, M = MP + MS;
constexpr int D = 1024, DIN = 3584, DSEG = 512, NH = 8, HD = 64, NGRP = 4, GA = 128, DPLE = 256, SEQ = 2048, NBP = 16, NBS = 128, TS = 8, WB = 2048;
constexpr size_t OUT_Y = 0, OUT_KWIN = (size_t)M * D, OUT_VWIN = OUT_KWIN + (size_t)MP * DSEG, OUT_KNEW = OUT_VWIN + (size_t)MP * DSEG, OUT_VNEW = OUT_KNEW + (size_t)MS * DSEG,
                 OUT_VACH = OUT_VNEW + (size_t)MS * DSEG, OUT_END = OUT_VACH + (size_t)MS * DSEG;
static_assert(OUT_END == 69730304, "output size");
using pg8::pk2; using pg8::bflo; using pg8::bfhi; using pg8::RMS_EPS; using pg8::fast_sigmoid;

constexpr size_t MiB = 1u << 20;
constexpr size_t WS_CTL = 0, CTL_ZERO_BYTES = 64 * 1024;
constexpr size_t WS_WIN = 2 * MiB, WS_WOUT = 10 * MiB, WS_WPLE = 12 * MiB, WS_WG = 13 * MiB, WS_WS = 15 * MiB;
constexpr size_t WS_RSTD = 15 * MiB + 512 * 1024, WS_RSTDE = 15 * MiB + 768 * 1024;
constexpr size_t WS_ESS = 16 * MiB;
constexpr size_t WS_PA = 20 * MiB, WS_PAL = 22 * MiB, WS_PBC = 23 * MiB, WS_PBCL = 39 * MiB;
constexpr size_t WS_XB = 40 * MiB, WS_PB = 106 * MiB, WS_SEG = 123 * MiB, SEG_BYTES = 33 * MiB;
constexpr size_t WS_MIX = 354 * MiB, WS_HB = 420 * MiB, WS_ERAW = 486 * MiB, WS_PO = 552 * MiB, WS_PL = 648 * MiB, WS_END = 652 * MiB;
static_assert((size_t)M * DSEG * 2 == SEG_BYTES && (size_t)M * D * 2 == 66 * MiB && (size_t)M * 16 * 4 <= 4 * MiB && (size_t)DIN * D * 2 <= 8 * MiB, "d_ws map");
enum Seg { SG_U = 0, SG_VA = 1, SG_ZA = 2, SG_Q = 3, SG_K = 4, SG_V = 5, SG_ZB = 6 };
constexpr int CW_TMO = 0, CW_CODE = 1, CW_QHEAD = 64, CW_BAR = 4096;

constexpr int RING_OFF = 0, RING_BYTES = 131072;
constexpr int LDSCTL_OFF = 147 * 1024, MISC_OFF = LDSCTL_OFF + 320;
constexpr int LDS_BYTES = 151552;
static_assert(MISC_OFF + 128 <= LDS_BYTES, "LDS map");

#define GAS __attribute__((address_space(1)))
#define LAS __attribute__((address_space(3)))
typedef unsigned short bf16;
typedef unsigned v4u __attribute__((ext_vector_type(4)));
typedef unsigned v2u __attribute__((ext_vector_type(2)));
typedef float f32x4 __attribute__((ext_vector_type(4)));
typedef float f32x16 __attribute__((ext_vector_type(16)));
typedef short bf16x8 __attribute__((ext_vector_type(8)));
typedef short s16x4 __attribute__((ext_vector_type(4)));
typedef GAS unsigned gu32;
#define RLX_AGENT __ATOMIC_RELAXED, __HIP_MEMORY_SCOPE_AGENT
#define LDS_WAIT() asm volatile("s_waitcnt lgkmcnt(0)" ::: "memory")
#define VM_WAIT() asm volatile("s_waitcnt vmcnt(0)" ::: "memory")
#define XB_TMO      128
#define XB_XCNT(j)  (256  + 64 * (j))
#define XB_XSUB(j)  (1280 + 64 * (j))
#define XB_XGEN(j)  (2304 + 64 * (j))
#define XB_TOP      3328
#define XB_TOPGEN   3392
#define XCD_BAR_WORDS 3456
#define XB_SPIN_CAP (1u << 18)

__device__ __forceinline__ unsigned xb_ld(unsigned* p)              { return __hip_atomic_load(p, __ATOMIC_RELAXED, __HIP_MEMORY_SCOPE_AGENT); }
__device__ __forceinline__ unsigned xb_add(unsigned* p, unsigned v) { return __hip_atomic_fetch_add(p, v, __ATOMIC_RELAXED, __HIP_MEMORY_SCOPE_AGENT); }
__device__ __forceinline__ unsigned xb_xcc_id() { return (unsigned)__builtin_amdgcn_s_getreg((3 << 11) | 20) & 0xFu; }
#define XB_SPIN(cond, bar) do { unsigned _sp = 0; while (cond) { __builtin_amdgcn_s_sleep(1); \
    if ((++_sp & 255u) == 0u) { if (xb_ld(&(bar)[XB_TMO])) break; if (_sp > XB_SPIN_CAP) { atomicAdd(&(bar)[XB_TMO], 1u); break; } } } } while (0)

struct XcdBarrier {
    int wave;
    unsigned* bar; unsigned x;
    volatile LAS unsigned* st;
};

__device__ __forceinline__ XcdBarrier xcd_barrier_post(unsigned* bar, volatile LAS unsigned* st) {
    XcdBarrier b; b.wave = (int)__builtin_amdgcn_readfirstlane((int)threadIdx.x >> 6); b.bar = bar; b.x = xb_xcc_id(); b.st = st;
    if (threadIdx.x == 0) (void)xb_add(&bar[XB_XCNT(b.x)], 1u);
    return b;
}
__device__ __forceinline__ void xcd_barrier_complete(unsigned* bar, unsigned x, unsigned& nloc, unsigned& nx) {
    const unsigned G = gridDim.x * gridDim.y * gridDim.z;
    unsigned sum, cnt, mine, sp = 0u;
    for (;;) {
        sum = 0u; cnt = 0u; mine = 0u;
#pragma unroll
        for (unsigned j = 0; j < 16; ++j) { const unsigned c = xb_ld(&bar[XB_XCNT(j)]); sum += c; cnt += (c > 0u) ? 1u : 0u; mine = (j == x) ? c : mine; }
        if (sum == G) break;
        __builtin_amdgcn_s_sleep(1);
        if ((++sp & 255u) == 0u) { if (xb_ld(&bar[XB_TMO])) break; if (sp > XB_SPIN_CAP) { atomicAdd(&bar[XB_TMO], 1u); break; } }
    }
    nloc = mine > 0u ? mine : 1u; nx = cnt > 0u ? cnt : 1u;
}

__device__ __forceinline__ void xcd_barrier(const XcdBarrier& b) {
    asm volatile("s_waitcnt vmcnt(0)" ::: "memory");
    __syncthreads();
    if (b.wave == 0 && __builtin_amdgcn_mbcnt_hi(~0u, __builtin_amdgcn_mbcnt_lo(~0u, 0u)) == 0u) {
        unsigned* bar = b.bar;
        __builtin_amdgcn_s_waitcnt(0);
        unsigned nloc = b.st[0], nx = b.st[1];
        if (nloc == 0u) { xcd_barrier_complete(bar, b.x, nloc, nx); b.st[0] = nloc; b.st[1] = nx; }
        const unsigned old = xb_add(&bar[XB_XSUB(b.x)], 1u);
        const unsigned gen = old / nloc;
        if (old + 1u == (gen + 1u) * nloc) {
            __builtin_amdgcn_fence(__ATOMIC_RELEASE, "agent");
            asm volatile("s_waitcnt vmcnt(0)" ::: "memory");
            const unsigned og = xb_add(&bar[XB_TOP], 1u);
            const unsigned tg = og / nx;
            if (og + 1u == (tg + 1u) * nx) xb_add(&bar[XB_TOPGEN], 1u);
            else XB_SPIN(xb_ld(&bar[XB_TOPGEN]) == tg, bar);
            __builtin_amdgcn_fence(__ATOMIC_ACQUIRE, "agent");
            xb_add(&bar[XB_XGEN(b.x)], 1u);
            asm volatile("s_waitcnt vmcnt(0)" ::: "memory");
        } else {
            XB_SPIN(xb_ld(&bar[XB_XGEN(b.x)]) == gen, bar);
            __builtin_amdgcn_fence(__ATOMIC_ACQUIRE, "agent");
            asm volatile("s_waitcnt vmcnt(0)" ::: "memory");
        }
    }
    __syncthreads();
}
struct Frame {
    LAS unsigned char* lds;
    volatile LAS unsigned* MISC;
    gu32* ctl;
    int wave;
    int vcu, G;
    float* out;
    unsigned char* ws;
};
__device__ __forceinline__ const float* inp(int k) { auto p = __builtin_amdgcn_kernarg_segment_ptr(); asm volatile("" : "+s"(p)); return ((const float* const*)p)[k]; }
__device__ __forceinline__ int lane_id() { return (int)__builtin_amdgcn_mbcnt_hi(~0u, __builtin_amdgcn_mbcnt_lo(~0u, 0u)); }
__device__ __forceinline__ bf16* segp(const Frame& F, int sg) { return ((bf16*)(F.ws + WS_SEG)) + (size_t)sg * (SEG_BYTES / 2); }
__device__ __forceinline__ float wave_sum(float v) {
#pragma unroll
    for (int o = 1; o < 64; o <<= 1) v += __shfl_xor(v, o);
    return v;
}

__device__ __forceinline__ void p0_transpose_item(const float* W, int K, int N, bf16* WT, const float* kscale, bool permute, LAS float* scr, int item, int lane) {
    const int nblk = N / 32, kb = item / nblk, nb = item % nblk, k0 = 64 * kb, n0 = 32 * nb;
#pragma unroll 8
    for (int i = 0; i < 32; ++i) { const int kk = 2 * i + (lane >> 5); scr[kk * 33 + (lane & 31)] = __builtin_nontemporal_load(W + (size_t)(k0 + kk) * N + n0 + (lane & 31)); }
    LDS_WAIT(); asm volatile("" ::: "memory");
    const int c = lane & 7;
    float ks[8];
#pragma unroll
    for (int e = 0; e < 8; ++e) ks[e] = kscale ? kscale[k0 + 8 * c + e] : 1.0f;
#pragma unroll
    for (int j = 0; j < 4; ++j) { const int n = (lane >> 3) + 8 * j; const LAS float* s = scr + (8 * c) * 33 + n;
        v4u o; o.x = pk2(s[0 * 33] * ks[0], s[1 * 33] * ks[1]); o.y = pk2(s[2 * 33] * ks[2], s[3 * 33] * ks[3]); o.z = pk2(s[4 * 33] * ks[4], s[5 * 33] * ks[5]); o.w = pk2(s[6 * 33] * ks[6], s[7 * 33] * ks[7]);
        int col = n0 + n, row = col;
        if (permute) { const int ol = col & 255; row = (col & ~255) + 128 * ((ol >> 5) & 1) + 32 * (ol >> 6) + (ol & 31); }
        *(GAS v4u*)(WT + (size_t)row * K + k0 + 8 * c) = o; }
    LDS_WAIT(); asm volatile("" ::: "memory");
}
__device__ __forceinline__ void p0_prologue(Frame& F) {
    const int lane = lane_id();
    LAS float* scr = (LAS float*)(F.lds + RING_OFF + F.wave * 16384);
    const int gw = F.vcu * NWAVES + F.wave, NGW = F.G * NWAVES;
    constexpr int I_IN = (D / 64) * (DIN / 32), I_OUT = (D / 64) * (D / 32), I_PLE = (DPLE / 64) * (D / 32), I_G = (D / 64) * (D / 32);
    constexpr int NITEMS = I_IN + I_OUT + I_PLE + I_G;
    for (int it = gw; it < NITEMS; it += NGW) {
        int r = it;
        if (r < I_IN) { p0_transpose_item(inp(7), D, DIN, ((bf16*)(F.ws + WS_WIN)), inp(6), true, scr, r, lane); continue; } r -= I_IN;
        if (r < I_OUT) { p0_transpose_item(inp(15), D, D, ((bf16*)(F.ws + WS_WOUT)), nullptr, true, scr, r, lane); continue; } r -= I_OUT;
        if (r < I_PLE) { p0_transpose_item(inp(16), DPLE, D, ((bf16*)(F.ws + WS_WPLE)), nullptr, true, scr, r, lane); continue; } r -= I_PLE;
        p0_transpose_item(inp(18), D, D, ((bf16*)(F.ws + WS_WG)), nullptr, true, scr, r, lane);
    }
    for (int i = gw * 64 + lane; i < NGRP * 128 * 128; i += NGW * 64) { const int s = i & 127, t = (i >> 7) & 127; const float w = (s <= t) ? inp(8)[i] : 0.f; ((bf16*)(F.ws + WS_WS))[i] = (bf16)(pk2(w, 0.f) & 0xffffu); }
    for (int m = gw; m < M; m += NGW) {
        const float* xrow = (m < MP) ? inp(0) + (size_t)m * D : inp(1) + (size_t)(m - MP) * D;
        const GAS f32x4* xr = (const GAS f32x4*)xrow + lane;
        f32x4 v[4]; float s2 = 0.f;
#pragma unroll
        for (int j = 0; j < 4; ++j) { v[j] = __builtin_nontemporal_load((const f32x4*)(xr + 64 * j)); s2 += (v[j].x * v[j].x + v[j].y * v[j].y) + (v[j].z * v[j].z + v[j].w * v[j].w); }
        s2 = wave_sum(s2);
        if (lane == 0) ((float*)(F.ws + WS_RSTD))[m] = 1.0f / sqrtf(s2 * (1.0f / D) + RMS_EPS);
        GAS v2u* o8 = (GAS v2u*)(((bf16*)(F.ws + WS_XB)) + (size_t)m * D) + lane;
#pragma unroll
        for (int j = 0; j < 4; ++j) { v2u o; o.x = pk2(v[j].x, v[j].y); o.y = pk2(v[j].z, v[j].w); o8[64 * j] = o; }
    }
    for (int i = gw; i < M / 2; i += NGW) {
        const int m = 2 * i; const float* prow = (m < MP) ? inp(4) + (size_t)m * DPLE : inp(5) + (size_t)(m - MP) * DPLE;
        const GAS f32x4* pr = (const GAS f32x4*)prow + 2 * lane; const f32x4 a = __builtin_nontemporal_load((const f32x4*)pr), b = __builtin_nontemporal_load((const f32x4*)(pr + 1));
        v4u o; o.x = pk2(a.x, a.y); o.y = pk2(a.z, a.w); o.z = pk2(b.x, b.y); o.w = pk2(b.z, b.w);
        *((GAS v4u*)(((bf16*)(F.ws + WS_PB)) + (size_t)m * DPLE) + lane) = o;
    }
}

#define DPP_F(v, ctrl) __builtin_bit_cast(float, __builtin_amdgcn_update_dpp(0, __builtin_bit_cast(int, (v)), (ctrl), 0xf, 0xf, true))
__device__ __forceinline__ void glds16_nt(const void* gsrc, unsigned lds_dst) { unsigned keep;
    asm volatile("s_mov_b32 %0, m0\n\ts_mov_b32 m0, %2\n\ts_nop 0\n\tglobal_load_lds_dwordx4 %1, off nt\n\ts_mov_b32 m0, %0" : "=&s"(keep) : "v"(gsrc), "s"(lds_dst) : "memory"); }
__device__ __forceinline__ float head_sum8(float s) { s += DPP_F(s, 0xB1); s += DPP_F(s, 0x4E); s += DPP_F(s, 0x141); return s; }
__device__ __forceinline__ void ld_q8(const bf16* qrow, int lane, float (&q)[8]) {
    const v4u w = *(const GAS v4u*)(qrow + 8 * lane);
    q[0] = bflo(w.x); q[1] = bfhi(w.x); q[2] = bflo(w.y); q[3] = bfhi(w.y); q[4] = bflo(w.z); q[5] = bfhi(w.z); q[6] = bflo(w.w); q[7] = bfhi(w.w);
}
struct SRow4 { f32x4 k0[4], k1[4], v0[4], v1[4]; };
__device__ __forceinline__ void srow4_load_nt(SRow4& R, const float* kp, const float* vp, size_t rstep) {
#pragma unroll
    for (int u = 0; u < 4; ++u) { R.k0[u] = __builtin_nontemporal_load((const f32x4*)(kp + u * rstep)); R.k1[u] = __builtin_nontemporal_load((const f32x4*)(kp + u * rstep + 4));
        R.v0[u] = __builtin_nontemporal_load((const f32x4*)(vp + u * rstep)); R.v1[u] = __builtin_nontemporal_load((const f32x4*)(vp + u * rstep + 4)); }
}
__device__ __forceinline__ void srow4_acc(const SRow4& R, int u, const float (&q)[8], float mult, float (&o)[8], float& l) {
    float s = (q[0] * R.k0[u].x + q[1] * R.k0[u].y) + (q[2] * R.k0[u].z + q[3] * R.k0[u].w) + (q[4] * R.k1[u].x + q[5] * R.k1[u].y) + (q[6] * R.k1[u].z + q[7] * R.k1[u].w);
    s = head_sum8(s); const float p = mult * __builtin_amdgcn_exp2f(s); l += p;
    o[0] += p * R.v0[u].x; o[1] += p * R.v0[u].y; o[2] += p * R.v0[u].z; o[3] += p * R.v0[u].w; o[4] += p * R.v1[u].x; o[5] += p * R.v1[u].y; o[6] += p * R.v1[u].z; o[7] += p * R.v1[u].w;
}
#define S_FENCE() asm volatile("" ::: "memory")
__device__ __forceinline__ void samp_unit(Frame& F, int b) {
    int lane = lane_id(); asm volatile("" : "+v"(lane));
    const int w = F.wave; const size_t m0 = (size_t)MP + b * TS;
    const float* ck = ((const float*)inp(2)) + (size_t)b * WB * DSEG + 8 * lane; const float* cv = ((const float*)inp(3)) + (size_t)b * WB * DSEG + 8 * lane;
    const float* nk = F.out + OUT_KNEW + (size_t)b * TS * DSEG + 8 * lane; const float* nv = F.out + OUT_VNEW + (size_t)b * TS * DSEG + 8 * lane;
    float oa[8], la = 0.f;
#pragma unroll
    for (int e = 0; e < 8; ++e) oa[e] = 0.f;
    float ob0[8], ob1[8], lb0 = 0.f, lb1 = 0.f;
#pragma unroll
    for (int e = 0; e < 8; ++e) { ob0[e] = 0.f; ob1[e] = 0.f; }
    LAS unsigned char* ring = F.lds + RING_OFF + w * 16384; const unsigned ring0 = (unsigned)(uintptr_t)ring;
#define S_DMA_ROW(slot, kp_, vp_) do { const unsigned d_ = (unsigned)__builtin_amdgcn_readfirstlane((int)(ring0 + (slot) * 4096)); \
        glds16_nt((kp_) + 4 * lane_, d_); glds16_nt((kp_) + 256 + 4 * lane_, d_ + 1024); glds16_nt((vp_) + 4 * lane_, d_ + 2048); glds16_nt((vp_) + 256 + 4 * lane_, d_ + 3072); } while (0)
#define S_LDS_ROW(slot, K0, K1, V0, V1) do { const LAS unsigned char* p_ = ring + (slot) * 4096 + 32 * lane_; K0 = *(const LAS f32x4*)p_; K1 = *(const LAS f32x4*)(p_ + 16); V0 = *(const LAS f32x4*)(p_ + 2048); V1 = *(const LAS f32x4*)(p_ + 2064); } while (0)
    const int lane_ = lane;
    const float* ck0 = ((const float*)inp(2)) + (size_t)b * WB * DSEG; const float* cv0 = ((const float*)inp(3)) + (size_t)b * WB * DSEG;
    { float q[8]; ld_q8(segp(F, SG_Q) + (m0 + w) * DSEG, lane, q);
      asm volatile("s_waitcnt vmcnt(0)" ::: "memory");
      const size_t rs = (size_t)16 * DSEG; const float* kb = ck0 + (size_t)w * DSEG; const float* vb = cv0 + (size_t)w * DSEG;
      S_DMA_ROW(0, kb, vb); S_DMA_ROW(1, kb + rs, vb + rs); S_DMA_ROW(2, kb + 2 * rs, vb + 2 * rs);
#pragma unroll 4
      for (int i = 0; i < 96; ++i) {
          { const int in = (i + 3 < 96) ? i + 3 : 95; S_DMA_ROW((i + 3) & 3, kb + (size_t)in * rs, vb + (size_t)in * rs); }
          asm volatile("s_waitcnt vmcnt(12)" ::: "memory");
          { SRow4 R; S_LDS_ROW(i & 3, R.k0[0], R.k1[0], R.v0[0], R.v1[0]); srow4_acc(R, 0, q, 1.0f, oa, la); }
          asm volatile("s_waitcnt lgkmcnt(0)" ::: "memory");
      }
      asm volatile("s_waitcnt vmcnt(0)" ::: "memory"); }
    { float q0[8], q1[8]; const int t0 = w & 3, t1 = t0 + 4; ld_q8(segp(F, SG_Q) + (m0 + t0) * DSEG, lane, q0); ld_q8(segp(F, SG_Q) + (m0 + t1) * DSEG, lane, q1);
      asm volatile("s_waitcnt vmcnt(0)" ::: "memory");
      const size_t rs = (size_t)8 * DSEG; const float* kb = ck0 + (size_t)(1536 + w) * DSEG; const float* vb = cv0 + (size_t)(1536 + w) * DSEG;
      S_DMA_ROW(0, kb, vb); S_DMA_ROW(1, kb + rs, vb + rs); S_DMA_ROW(2, kb + 2 * rs, vb + 2 * rs);
#pragma unroll 4
      for (int i = 0; i < 48; ++i) {
          { const int in = (i + 3 < 48) ? i + 3 : 47; S_DMA_ROW((i + 3) & 3, kb + (size_t)in * rs, vb + (size_t)in * rs); }
          asm volatile("s_waitcnt vmcnt(12)" ::: "memory");
          { SRow4 R; S_LDS_ROW(i & 3, R.k0[0], R.k1[0], R.v0[0], R.v1[0]); const int rho = 1536 + w + 8 * i, d0 = WB + t0 - rho, d1 = WB + t1 - rho;
            srow4_acc(R, 0, q0, (d0 <= 512 ? 1.0f : 0.0f) + ((d0 & 15) == 0 ? 1.0f : 0.0f), ob0, lb0); srow4_acc(R, 0, q1, (d1 <= 512 ? 1.0f : 0.0f) + ((d1 & 15) == 0 ? 1.0f : 0.0f), ob1, lb1); }
          asm volatile("s_waitcnt lgkmcnt(0)" ::: "memory");
      }
      asm volatile("s_waitcnt vmcnt(0)" ::: "memory"); }
#undef S_DMA_ROW
#undef S_LDS_ROW
    __syncthreads();
    float q[8][8], o[8][8], l[8];
#pragma unroll
    for (int t = 0; t < 8; ++t) { ld_q8(segp(F, SG_Q) + (m0 + t) * DSEG, lane, q[t]);
        const bool a0 = (t == (w & 3)), a1 = (t == (w & 3) + 4);
        l[t] = a0 ? lb0 : (a1 ? lb1 : 0.f);
#pragma unroll
        for (int e = 0; e < 8; ++e) o[t][e] = a0 ? ob0[e] : (a1 ? ob1[e] : 0.f); }
    for (int i0 = 0; i0 < 20; i0 += 4) {
        f32x4 k0[4], k1[4], v0[4], v1[4]; int rho[4];
#pragma unroll
        for (int u = 0; u < 4; ++u) { const int i = i0 + u, ic = i < 16 ? i : 16; rho[u] = (i <= 16) ? 1920 + w + 8 * ic : 100000; const int rr = 1920 + w + 8 * ic;
            const float* kr = (rr < WB) ? ck + (size_t)rr * DSEG : nk + (size_t)(rr - WB) * DSEG; const float* vr = (rr < WB) ? cv + (size_t)rr * DSEG : nv + (size_t)(rr - WB) * DSEG;
            k0[u] = *(const f32x4*)kr; k1[u] = *(const f32x4*)(kr + 4); v0[u] = *(const f32x4*)vr; v1[u] = *(const f32x4*)(vr + 4); }
#pragma unroll
        for (int u = 0; u < 4; ++u) {
#pragma unroll
            for (int t = 0; t < 8; ++t) {
                const int dl = WB + t - rho[u];
                const int mult = (dl >= 0 && dl <= 128 ? 1 : 0) + (dl >= 0 && (dl & 3) == 0 && dl <= 512 ? 1 : 0) + (dl >= 0 && (dl & 15) == 0 ? 1 : 0);
                if (mult) {
                    float s = (q[t][0] * k0[u].x + q[t][1] * k0[u].y) + (q[t][2] * k0[u].z + q[t][3] * k0[u].w) + (q[t][4] * k1[u].x + q[t][5] * k1[u].y) + (q[t][6] * k1[u].z + q[t][7] * k1[u].w);
                    s = head_sum8(s); const float p = (float)mult * __builtin_amdgcn_exp2f(s); l[t] += p;
                    o[t][0] += p * v0[u].x; o[t][1] += p * v0[u].y; o[t][2] += p * v0[u].z; o[t][3] += p * v0[u].w; o[t][4] += p * v1[u].x; o[t][5] += p * v1[u].y; o[t][6] += p * v1[u].z; o[t][7] += p * v1[u].w; }
            }
        }
    }
    LAS float* mb = (LAS float*)(F.lds + RING_OFF);
#pragma unroll
    for (int rnd = 0; rnd < 2; ++rnd) {
#pragma unroll
        for (int tq = 0; tq < 4; ++tq) { LAS float* sl = mb + (w * 4 + tq) * 576 + lane * 9;
#pragma unroll
            for (int e = 0; e < 8; ++e) sl[e] = o[4 * rnd + tq][e];
            sl[8] = l[4 * rnd + tq]; }
        __syncthreads();
        if ((w >> 2) == rnd) { const int tq = w & 3;
#pragma unroll
            for (int ww = 0; ww < 8; ++ww) { const LAS float* sl = mb + (ww * 4 + tq) * 576 + lane * 9;
#pragma unroll
                for (int e = 0; e < 8; ++e) oa[e] += sl[e];
                la += sl[8]; } }
        __syncthreads();
    }
    const float inv = 1.0f / la; float ss = 0.f;
#pragma unroll
    for (int e = 0; e < 8; ++e) { oa[e] *= inv; ss += oa[e] * oa[e]; }
    ss = head_sum8(ss);
    const float rn = 1.0f / sqrtf(ss * (1.0f / HD) + RMS_EPS);
    const f32x4 g0 = *(const f32x4*)(inp(14) + 8 * lane), g1 = *(const f32x4*)(inp(14) + 8 * lane + 4);
    const size_t m = m0 + w;
    const v4u z = *(const GAS v4u*)(segp(F, SG_ZB) + m * DSEG + 8 * lane);
    v4u wv; wv.x = pk2(oa[0] * rn * g0.x * bflo(z.x), oa[1] * rn * g0.y * bfhi(z.x)); wv.y = pk2(oa[2] * rn * g0.z * bflo(z.y), oa[3] * rn * g0.w * bfhi(z.y));
    wv.z = pk2(oa[4] * rn * g1.x * bflo(z.z), oa[5] * rn * g1.y * bfhi(z.z)); wv.w = pk2(oa[6] * rn * g1.z * bflo(z.w), oa[7] * rn * g1.w * bfhi(z.w));
    *(GAS v4u*)(((bf16*)(F.ws + WS_MIX)) + m * D + DSEG + 8 * lane) = wv;
}

constexpr int VN_PITCH = 272, GM_VN = 0, GM_U = 128 * VN_PITCH, GM_Z = 2 * 128 * VN_PITCH, GM_P = 3 * 128 * VN_PITCH;
__device__ __forceinline__ s16x4 tr16(const LAS unsigned char* p) { return __builtin_bit_cast(s16x4, __builtin_amdgcn_ds_read_tr16_b64_v4i16((LAS s16x4*)p)); }
struct GmRegs { v4u rv[4], ru[4], rz[4]; bf16x8 wf[4]; };
__device__ __forceinline__ void gmlp_load(Frame& F, GmRegs& R, int m0, int g, int lane, int w) {
    const int tid = w * 64 + lane, t = 16 * w + (lane & 15), gq4 = lane >> 4;
    const size_t roff = (size_t)(m0 + (tid >> 4)) * DSEG + g * GA + 8 * (tid & 15);
    const bf16* pv = segp(F, SG_VA) + roff; const bf16* pu = segp(F, SG_U) + roff; const bf16* pz = segp(F, SG_ZA) + roff;
#pragma unroll
    for (int i = 0; i < 4; ++i) R.rv[i] = __builtin_nontemporal_load((const v4u*)(pv + (size_t)(32 * i) * DSEG));
    const bf16* wsrow = ((bf16*)(F.ws + WS_WS)) + ((size_t)g * 128 + t) * 128 + 8 * gq4;
#pragma unroll
    for (int ks = 0; ks < 4; ++ks) R.wf[ks] = *(const GAS bf16x8*)(wsrow + 32 * ks);
#pragma unroll
    for (int i = 0; i < 4; ++i) { R.ru[i] = __builtin_nontemporal_load((const v4u*)(pu + (size_t)(32 * i) * DSEG)); R.rz[i] = __builtin_nontemporal_load((const v4u*)(pz + (size_t)(32 * i) * DSEG)); }
}
__device__ __forceinline__ void gmlp_compute(Frame& F, const GmRegs& R, int m0, int g, int lane, int w) {
    LAS unsigned char* img = F.lds + RING_OFF;
    const int tid = w * 64 + lane, srow = tid >> 4, sch = tid & 15;
    const int t = 16 * w + (lane & 15), gq4 = lane >> 4;
    { const LAS float* gv = (const LAS float*)(img + GM_P) + g * GA + 8 * sch;
      const f32x4 ga = *(const LAS f32x4*)gv, gb = *(const LAS f32x4*)(gv + 4);
#pragma unroll
      for (int i = 0; i < 4; ++i) { const v4u r = R.rv[i]; float f[8];
          f[0] = bflo(r.x); f[1] = bfhi(r.x); f[2] = bflo(r.y); f[3] = bfhi(r.y); f[4] = bflo(r.z); f[5] = bfhi(r.z); f[6] = bflo(r.w); f[7] = bfhi(r.w);
          float ss = (f[0] * f[0] + f[1] * f[1]) + (f[2] * f[2] + f[3] * f[3]) + (f[4] * f[4] + f[5] * f[5]) + (f[6] * f[6] + f[7] * f[7]);
          ss += DPP_F(ss, 0xB1); ss += DPP_F(ss, 0x4E); ss += DPP_F(ss, 0x141); ss += DPP_F(ss, 0x140);
          const float rn = 1.0f / sqrtf(ss * (1.0f / GA) + RMS_EPS);
          v4u o; o.x = pk2(f[0] * rn * ga.x, f[1] * rn * ga.y); o.y = pk2(f[2] * rn * ga.z, f[3] * rn * ga.w); o.z = pk2(f[4] * rn * gb.x, f[5] * rn * gb.y); o.w = pk2(f[6] * rn * gb.z, f[7] * rn * gb.w);
          const int off = (32 * i + srow) * VN_PITCH + 16 * sch;
          *(LAS v4u*)(img + GM_VN + off) = o; *(LAS v4u*)(img + GM_U + off) = R.ru[i]; *(LAS v4u*)(img + GM_Z + off) = R.rz[i]; } }
    __syncthreads();
    f32x4 acc[8];
#pragma unroll
    for (int ct = 0; ct < 8; ++ct) acc[ct] = (f32x4){0.f, 0.f, 0.f, 0.f};
    const int q4 = (lane & 15) >> 2, p4 = lane & 3;
    const LAS unsigned char* trb = img + GM_VN + (8 * gq4 + q4) * VN_PITCH + 8 * p4;
    const int nks = (16 * w + 15) / 32 + 1;
#pragma unroll
    for (int ks = 0; ks < 4; ++ks) {
        if (ks < nks) {
#pragma unroll
            for (int ct = 0; ct < 8; ++ct) {
                const s16x4 lo = tr16(trb + (32 * ks) * VN_PITCH + 32 * ct), hi = tr16(trb + (32 * ks + 4) * VN_PITCH + 32 * ct);
                const bf16x8 vf = (bf16x8){lo[0], lo[1], lo[2], lo[3], hi[0], hi[1], hi[2], hi[3]};
                acc[ct] = __builtin_amdgcn_mfma_f32_16x16x32_bf16(vf, R.wf[ks], acc[ct], 0, 0, 0);
            } } }
    const float bs = ((const LAS float*)(img + GM_P))[1024 + g * 128 + t];
    LAS unsigned char* urow = img + GM_U + t * VN_PITCH + 8 * gq4; const LAS unsigned char* zrow = img + GM_Z + t * VN_PITCH + 8 * gq4;
    float a[8][4]; float ss = 0.f;
#pragma unroll
    for (int ct = 0; ct < 8; ++ct) { const v2u uu = *(const LAS v2u*)(urow + 32 * ct);
        a[ct][0] = bflo(uu.x) * (acc[ct][0] + bs); a[ct][1] = bfhi(uu.x) * (acc[ct][1] + bs); a[ct][2] = bflo(uu.y) * (acc[ct][2] + bs); a[ct][3] = bfhi(uu.y) * (acc[ct][3] + bs);
        ss += (a[ct][0] * a[ct][0] + a[ct][1] * a[ct][1]) + (a[ct][2] * a[ct][2] + a[ct][3] * a[ct][3]); }
    ss += __shfl_xor(ss, 16); ss += __shfl_xor(ss, 32);
    const float rn = 1.0f / sqrtf(ss * (1.0f / GA) + RMS_EPS);
#pragma unroll
    for (int ct = 0; ct < 8; ++ct) { const v2u zz = *(const LAS v2u*)(zrow + 32 * ct); const f32x4 go = *(const LAS f32x4*)((const LAS float*)(img + GM_P) + 512 + g * GA + 16 * ct + 4 * gq4);
        v2u o; o.x = pk2(a[ct][0] * rn * go.x * bflo(zz.x), a[ct][1] * rn * go.y * bfhi(zz.x)); o.y = pk2(a[ct][2] * rn * go.z * bflo(zz.y), a[ct][3] * rn * go.w * bfhi(zz.y));
        *(LAS v2u*)(urow + 32 * ct) = o; }
    __syncthreads();
    { bf16* po = ((bf16*)(F.ws + WS_MIX)) + (size_t)(m0 + srow) * D + g * GA + 8 * sch;
#pragma unroll
      for (int i = 0; i < 4; ++i) *(GAS v4u*)(po + (size_t)(32 * i) * D) = *(const LAS v4u*)(img + GM_U + (32 * i + srow) * VN_PITCH + 16 * sch); }
    __syncthreads();
}
__device__ __forceinline__ void gmlp_batch(Frame& F, int m0) {
    int lane = lane_id(); asm volatile("" : "+v"(lane)); const int w = F.wave;
    GmRegs R0, R1;
    { LAS float* pt = (LAS float*)(F.lds + RING_OFF + GM_P); const int tid = w * 64 + lane;
      pt[tid] = inp(10)[tid]; pt[512 + tid] = inp(11)[tid]; pt[1024 + tid] = inp(9)[tid]; }
    gmlp_load(F, R0, m0, 0, lane, w);
    __syncthreads();
    gmlp_load(F, R1, m0, 1, lane, w); gmlp_compute(F, R0, m0, 0, lane, w);
    gmlp_load(F, R0, m0, 2, lane, w); gmlp_compute(F, R1, m0, 1, lane, w);
    gmlp_load(F, R1, m0, 3, lane, w); gmlp_compute(F, R0, m0, 2, lane, w);
    gmlp_compute(F, R1, m0, 3, lane, w);
}
__device__ __forceinline__ void gmlp_sample_task(Frame& F, int b, int g) {
    int lane = lane_id(); asm volatile("" : "+v"(lane)); const int c = g * GA + 2 * lane; const size_t m0 = (size_t)MP + b * TS;
    float vn0[8], vn1[8];
    const float gv0 = inp(10)[c], gv1 = inp(10)[c + 1], go0 = inp(11)[c], go1 = inp(11)[c + 1];
#pragma unroll
    for (int t = 0; t < 8; ++t) {
        const unsigned r = *(const GAS unsigned*)(segp(F, SG_VA) + (m0 + t) * DSEG + c); const float a0 = bflo(r), a1 = bfhi(r);
        const float ss = wave_sum(a0 * a0 + a1 * a1); const float rn = 1.0f / sqrtf(ss * (1.0f / GA) + RMS_EPS);
        vn0[t] = a0 * rn * gv0; vn1[t] = a1 * rn * gv1;
        float* vo = F.out + OUT_VACH + ((size_t)b * TS + t) * DSEG + c; vo[0] = vn0[t]; vo[1] = vn1[t];
    }
#pragma unroll
    for (int t = 0; t < 8; ++t) {
        float m0v = inp(9)[g * 128 + t], m1v = m0v;
#pragma unroll
        for (int s = 0; s <= t; ++s) { const float w = inp(8)[((size_t)g * 128 + t) * 128 + s]; m0v += w * vn0[s]; m1v += w * vn1[s]; }
        const unsigned ur = *(const GAS unsigned*)(segp(F, SG_U) + (m0 + t) * DSEG + c), zr = *(const GAS unsigned*)(segp(F, SG_ZA) + (m0 + t) * DSEG + c);
        const float a0 = bflo(ur) * m0v, a1 = bfhi(ur) * m1v;
        const float ss = wave_sum(a0 * a0 + a1 * a1); const float rn = 1.0f / sqrtf(ss * (1.0f / GA) + RMS_EPS);
        *(GAS unsigned*)(((bf16*)(F.ws + WS_MIX)) + (m0 + t) * D + c) = pk2(a0 * rn * go0 * bflo(zr), a1 * rn * go1 * bfhi(zr));
    }
}

constexpr int TJ_SLOT = 32768, TJ_NSLOT = 4, TJ_X = TJ_NSLOT * TJ_SLOT, TJ_XB = 4608;
static_assert(TJ_X + 4 * TJ_XB <= LDSCTL_OFF, "attention LDS");
__device__ __forceinline__ int crow(int reg, int h2) { return (reg & 3) + 8 * (reg >> 2) + 4 * h2; }
__device__ __forceinline__ void glds16(const void* gsrc, unsigned lds_dst) { unsigned keep;
    asm volatile("s_mov_b32 %0, m0\n\ts_mov_b32 m0, %2\n\ts_nop 0\n\tglobal_load_lds_dwordx4 %1, off\n\ts_mov_b32 m0, %0" : "=&s"(keep) : "v"(gsrc), "s"(lds_dst) : "memory"); }
__device__ __forceinline__ void tj_dma_block(const bf16* Kg, const bf16* Vg, int r, int c, int kb, unsigned lds0, int slot, int w, int lane) {
#pragma unroll
    for (int pi = 0; pi < 2; ++pi) { const int i = w + 8 * pi, row = 8 * i + (lane >> 3), cp = lane & 7;
        const size_t rowoff = (size_t)(c + r * (kb + row)) * DSEG;
        glds16(Kg + rowoff + 8 * (cp ^ ((row >> 1) & 7)), (unsigned)__builtin_amdgcn_readfirstlane((int)(lds0 + slot * TJ_SLOT + i * 1024)));
        glds16(Vg + rowoff + 8 * (cp ^ (4 * ((row >> 1) & 1))), (unsigned)__builtin_amdgcn_readfirstlane((int)(lds0 + slot * TJ_SLOT + 16384 + i * 1024))); }
}
__device__ __forceinline__ void tj_unit(Frame& F, int b, int h, int type, int x) {
    int lane = lane_id(); asm volatile("" : "+v"(lane));
    const int w = F.wave, r32 = lane & 31, h2 = lane >> 5, a = w & 3, hh = w >> 2;
    const int r = (type == 0) ? 1 : (type == 1 ? 4 : 16);
    const size_t hb = (size_t)b * SEQ * DSEG + h * HD;
    const bf16 *Qg = segp(F, SG_Q) + hb, *Kg = segp(F, SG_K) + hb, *Vg = segp(F, SG_V) + hb;
    bf16* PO = (bf16*)(F.ws + WS_PO) + (size_t)type * ((size_t)MP * DSEG) + hb; float* PL = (float*)(F.ws + WS_PL) + (size_t)type * ((size_t)MP * NH) + (size_t)b * SEQ * NH + h;
    LAS unsigned char* L = F.lds + RING_OFF; const unsigned lds0 = (unsigned)(uintptr_t)L;
    const int lead = (type == 0 && x == 1) ? 1 : 0, nent = 8 + lead;
#define TJ_JC(jj) ((type == 0) ? 0 : ((type == 1) ? 2 * x + ((jj) >> 2) : 8 * x + (jj)))
#define TJ_JN(jj) ((type == 0) ? 8 * x + (jj) : ((type == 1) ? ((jj) & 3) : 0))
#define TJ_EC(e) ((type == 0) ? 0 : ((type == 1) ? 2 * x + ((e) >> 2) : 8 * x + (e)))
#define TJ_EN(e) ((type == 0) ? 8 * x + (e) - lead : ((type == 1) ? ((e) & 3) : 0))
#define TJ_QROW(jj) (Qg + (size_t)(TJ_JC(jj) + r * (128 * TJ_JN(jj) + 32 * a + r32)) * DSEG + 8 * h2)
    for (int e = 0; e <= lead + 1; ++e) tj_dma_block(Kg, Vg, r, TJ_EC(e), 128 * TJ_EN(e), lds0, e & 3, w, lane);
    bf16x8 qf[4], qa[4];
    { const bf16* q0 = TJ_QROW(0); const bf16* q1 = TJ_QROW(1);
#pragma unroll
      for (int st = 0; st < 4; ++st) { qf[st] = *(const GAS bf16x8*)(q0 + 16 * st); qa[st] = *(const GAS bf16x8*)(q1 + 16 * st); } }
    asm volatile("s_waitcnt vmcnt(0) lgkmcnt(0)" ::: "memory"); __builtin_amdgcn_s_barrier(); asm volatile("" ::: "memory");
    asm volatile("" : "+v"(qf[0]), "+v"(qf[1]), "+v"(qf[2]), "+v"(qf[3]), "+v"(qa[0]), "+v"(qa[1]), "+v"(qa[2]), "+v"(qa[3]));
    const int q4 = (lane & 15) >> 2, p4 = lane & 3, blk = (lane >> 4) & 1;
    const int kswz = (r32 >> 1) & 7, vswz = 4 * ((q4 >> 1) & 1);
#pragma unroll 1
    for (int jj = 0; jj < 8; ++jj) {
        const int cj = TJ_JC(jj), nj = TJ_JN(jj), ci = jj + lead; const bool has_prev = nj > 0, fin = (hh == (jj & 1));
        const int prev_slot = (ci + 3) & 3, cur_slot = ci & 3;
        bf16x8 qb[4];
        { const int j2 = (jj + 2 < 8) ? jj + 2 : 7; const bf16* q2 = TJ_QROW(j2);
#pragma unroll
          for (int st = 0; st < 4; ++st) asm volatile("global_load_dwordx4 %0, %1, off" : "=v"(qb[st]) : "v"(q2 + 16 * st) : "memory"); }
        const bool dma = (ci + 2 < nent);
        if (dma) tj_dma_block(Kg, Vg, r, TJ_EC(ci + 2), 128 * TJ_EN(ci + 2), lds0, (ci + 2) & 3, w, lane);
        f32x16 o0, o1; float lsum = 0.f;
#pragma unroll
        for (int i = 0; i < 16; ++i) { o0[i] = 0.f; o1[i] = 0.f; }
        const int jlo = fin ? a + 3 : a, jhi = fin ? a + 4 : a + 2;
#pragma unroll 1
        for (int j = jlo; j <= jhi; ++j) {
            if (j < 4 && !has_prev) continue;
            const LAS unsigned char* sl = L + ((j < 4) ? prev_slot : cur_slot) * TJ_SLOT + 32 * (j & 3) * 128;
            bf16x8 kf[4];
#pragma unroll
            for (int st = 0; st < 4; ++st) kf[st] = *(const LAS bf16x8*)(sl + r32 * 128 + 16 * ((2 * st + h2) ^ kswz));
            f32x16 xx;
#pragma unroll
            for (int i = 0; i < 16; ++i) xx[i] = 0.f;
#pragma unroll
            for (int st = 0; st < 4; ++st) xx = __builtin_amdgcn_mfma_f32_32x32x16_bf16(kf[st], qf[st], xx, 0, 0, 0);
            const bool mfirst = (j == a), mlast = (j == a + 4); float ps = 0.f;
            if (mfirst || mlast) {
#pragma unroll
                for (int i = 0; i < 16; ++i) { const int kr = crow(i, h2); const bool valid = (!mfirst || kr >= r32) && (!mlast || kr <= r32);
                    const float p = valid ? __builtin_amdgcn_exp2f(xx[i]) : 0.f; xx[i] = p; ps += p; }
            } else {
#pragma unroll
                for (int i = 0; i < 16; ++i) { const float p = __builtin_amdgcn_exp2f(xx[i]); xx[i] = p; ps += p; }
            }
            lsum += ps;
            v4u pw0, pw1; pw0.x = pk2(xx[0], xx[1]); pw0.y = pk2(xx[2], xx[3]); pw0.z = pk2(xx[4], xx[5]); pw0.w = pk2(xx[6], xx[7]);
            pw1.x = pk2(xx[8], xx[9]); pw1.y = pk2(xx[10], xx[11]); pw1.z = pk2(xx[12], xx[13]); pw1.w = pk2(xx[14], xx[15]);
            const bf16x8 pf0 = __builtin_bit_cast(bf16x8, pw0), pf1 = __builtin_bit_cast(bf16x8, pw1);
            const LAS unsigned char* vb = sl + 16384 + (4 * h2 + q4) * 128 + 8 * (p4 & 1);
            const int ch0 = (2 * blk + (p4 >> 1)) ^ vswz, ch1 = (4 + 2 * blk + (p4 >> 1)) ^ vswz;
            const s16x4 a0 = tr16(vb + 0 * 128 + 16 * ch0), a1 = tr16(vb + 8 * 128 + 16 * ch0), b0 = tr16(vb + 16 * 128 + 16 * ch0), b1 = tr16(vb + 24 * 128 + 16 * ch0);
            const s16x4 c0v = tr16(vb + 0 * 128 + 16 * ch1), c1v = tr16(vb + 8 * 128 + 16 * ch1), d0v = tr16(vb + 16 * 128 + 16 * ch1), d1v = tr16(vb + 24 * 128 + 16 * ch1);
            const bf16x8 v00 = (bf16x8){a0[0], a0[1], a0[2], a0[3], a1[0], a1[1], a1[2], a1[3]}, v01 = (bf16x8){b0[0], b0[1], b0[2], b0[3], b1[0], b1[1], b1[2], b1[3]};
            const bf16x8 v10 = (bf16x8){c0v[0], c0v[1], c0v[2], c0v[3], c1v[0], c1v[1], c1v[2], c1v[3]}, v11 = (bf16x8){d0v[0], d0v[1], d0v[2], d0v[3], d1v[0], d1v[1], d1v[2], d1v[3]};
            o0 = __builtin_amdgcn_mfma_f32_32x32x16_bf16(v00, pf0, o0, 0, 0, 0); o0 = __builtin_amdgcn_mfma_f32_32x32x16_bf16(v01, pf1, o0, 0, 0, 0);
            o1 = __builtin_amdgcn_mfma_f32_32x32x16_bf16(v10, pf0, o1, 0, 0, 0); o1 = __builtin_amdgcn_mfma_f32_32x32x16_bf16(v11, pf1, o1, 0, 0, 0);
        }
        lsum += __shfl_xor(lsum, 32);
        LAS unsigned* xs = (LAS unsigned*)(L + TJ_X + a * TJ_XB) + lane * 17;
        if (!fin) {
#pragma unroll
            for (int i = 0; i < 8; ++i) { xs[i] = pk2(o0[2 * i], o0[2 * i + 1]); xs[8 + i] = pk2(o1[2 * i], o1[2 * i + 1]); }
            xs[16] = __float_as_uint(lsum); }
        if (dma) asm volatile("s_waitcnt vmcnt(4) lgkmcnt(0)" ::: "memory"); else asm volatile("s_waitcnt vmcnt(0) lgkmcnt(0)" ::: "memory");
        __builtin_amdgcn_s_barrier(); asm volatile("" ::: "memory");
        asm volatile("" : "+v"(qb[0]), "+v"(qb[1]), "+v"(qb[2]), "+v"(qb[3]));
#pragma unroll
        for (int st = 0; st < 4; ++st) { qf[st] = qa[st]; qa[st] = qb[st]; }
        if (fin) {
#pragma unroll
            for (int i = 0; i < 8; ++i) { const unsigned ua = xs[i], ub = xs[8 + i]; o0[2 * i] += bflo(ua); o0[2 * i + 1] += bfhi(ua); o1[2 * i] += bflo(ub); o1[2 * i + 1] += bfhi(ub); }
            lsum += __uint_as_float(xs[16]);
            LAS unsigned char* stg = L + TJ_X + a * TJ_XB;
            asm volatile("s_waitcnt lgkmcnt(0)" ::: "memory");
#pragma unroll
            for (int g = 0; g < 4; ++g) { v2u ua; ua.x = pk2(o0[4 * g], o0[4 * g + 1]); ua.y = pk2(o0[4 * g + 2], o0[4 * g + 3]); *(LAS v2u*)(stg + r32 * 144 + 8 * h2 + 16 * g) = ua;
                v2u uc; uc.x = pk2(o1[4 * g], o1[4 * g + 1]); uc.y = pk2(o1[4 * g + 2], o1[4 * g + 3]); *(LAS v2u*)(stg + r32 * 144 + 64 + 8 * h2 + 16 * g) = uc; }
            asm volatile("s_waitcnt lgkmcnt(0)" ::: "memory");
            const size_t pos0 = (size_t)(cj + r * (128 * nj + 32 * a));
#pragma unroll
            for (int i = 0; i < 4; ++i) { const int row = 8 * i + (lane >> 3), ch = lane & 7; const v4u v = *(const LAS v4u*)(stg + row * 144 + 16 * ch);
                *(GAS v4u*)(PO + (pos0 + (size_t)r * row) * DSEG + 8 * ch) = v; }
            if (h2 == 0) PL[(pos0 + (size_t)r * r32) * NH] = lsum;
        }
    }
#undef TJ_JC
#undef TJ_JN
#undef TJ_EC
#undef TJ_EN
#undef TJ_QROW
    asm volatile("s_waitcnt vmcnt(0) lgkmcnt(0)" ::: "memory"); __builtin_amdgcn_s_barrier(); asm volatile("" ::: "memory");
}
struct FinRow { v4u p0, p1, p2, z; float l0, l1, l2; };
__device__ __forceinline__ FinRow fin_load(Frame& F, size_t m, int lane) {
    FinRow r; const bf16* po = (const bf16*)(F.ws + WS_PO) + m * DSEG + 8 * lane; const float* pl = (const float*)(F.ws + WS_PL) + m * NH + (lane >> 3);
    r.p0 = *(const GAS v4u*)po; r.p1 = *(const GAS v4u*)(po + (size_t)MP * DSEG); r.p2 = *(const GAS v4u*)(po + 2 * (size_t)MP * DSEG);
    r.l0 = pl[0]; r.l1 = pl[(size_t)MP * NH]; r.l2 = pl[2 * (size_t)MP * NH];
    r.z = __builtin_nontemporal_load((const v4u*)(segp(F, SG_ZB) + m * DSEG + 8 * lane));
    return r;
}
__device__ __forceinline__ void fin_store(Frame& F, size_t m, int lane, const FinRow& r, const f32x4 g0, const f32x4 g1) {
    const v4u p0 = r.p0, p1 = r.p1, p2 = r.p2, z = r.z;
    const float l = r.l0 + r.l1 + r.l2;
    const float inv = 1.0f / l; float o[8];
    o[0] = (bflo(p0.x) + bflo(p1.x) + bflo(p2.x)) * inv; o[1] = (bfhi(p0.x) + bfhi(p1.x) + bfhi(p2.x)) * inv; o[2] = (bflo(p0.y) + bflo(p1.y) + bflo(p2.y)) * inv; o[3] = (bfhi(p0.y) + bfhi(p1.y) + bfhi(p2.y)) * inv;
    o[4] = (bflo(p0.z) + bflo(p1.z) + bflo(p2.z)) * inv; o[5] = (bfhi(p0.z) + bfhi(p1.z) + bfhi(p2.z)) * inv; o[6] = (bflo(p0.w) + bflo(p1.w) + bflo(p2.w)) * inv; o[7] = (bfhi(p0.w) + bfhi(p1.w) + bfhi(p2.w)) * inv;
    float ss = 0.f;
#pragma unroll
    for (int e = 0; e < 8; ++e) ss += o[e] * o[e];
    ss = head_sum8(ss);
    const float rn = 1.0f / sqrtf(ss * (1.0f / HD) + RMS_EPS);
    v4u wv; wv.x = pk2(o[0] * rn * g0.x * bflo(z.x), o[1] * rn * g0.y * bfhi(z.x)); wv.y = pk2(o[2] * rn * g0.z * bflo(z.y), o[3] * rn * g0.w * bfhi(z.y));
    wv.z = pk2(o[4] * rn * g1.x * bflo(z.z), o[5] * rn * g1.y * bfhi(z.z)); wv.w = pk2(o[6] * rn * g1.z * bflo(z.w), o[7] * rn * g1.w * bfhi(z.w));
    *(GAS v4u*)(((bf16*)(F.ws + WS_MIX)) + m * D + DSEG + 8 * lane) = wv;
}
constexpr int FIN_RB = 4;
__device__ __forceinline__ void attn_finish_pass(Frame& F, int gw, int NGW) {
    const int lane = lane_id();
    const f32x4 g0 = *(const f32x4*)(inp(14) + 8 * lane), g1 = *(const f32x4*)(inp(14) + 8 * lane + 4);
    if (gw >= MP) return;
    FinRow cur[FIN_RB];
#pragma unroll
    for (int k = 0; k < FIN_RB; ++k) { const size_t m = (size_t)gw + (size_t)k * NGW; cur[k] = fin_load(F, m < (size_t)MP ? m : (size_t)gw, lane); }
    for (size_t mb = (size_t)gw; mb < (size_t)MP; mb += (size_t)FIN_RB * NGW) {
        FinRow nxt[FIN_RB];
#pragma unroll
        for (int k = 0; k < FIN_RB; ++k) { const size_t m = mb + (size_t)(FIN_RB + k) * NGW; nxt[k] = fin_load(F, m < (size_t)MP ? m : (size_t)gw, lane); }
        asm volatile("" ::: "memory");
#pragma unroll
        for (int k = 0; k < FIN_RB; ++k) { const size_t m = mb + (size_t)k * NGW; if (m < (size_t)MP) fin_store(F, m, lane, cur[k], g0, g1); }
#pragma unroll
        for (int k = 0; k < FIN_RB; ++k) cur[k] = nxt[k];
    }
}

constexpr int ST_PITCH = 68;
template <int MODE  > __device__ __forceinline__ void small_tile(Frame& F, int tile, const bf16* A, const bf16* Bt) {
    const int lane = lane_id(), w = F.wave, tm = tile >> 4, tn = tile & 15;
    const int l15 = lane & 15, lq = lane >> 4;
    const bf16* ap = A + (size_t)(MP + tm * 64 + l15) * D + 128 * w + 8 * lq;
    const bf16* bp = Bt + (size_t)(tn * 64 + l15) * D + 128 * w + 8 * lq;
    f32x4 acc[4][4];
#pragma unroll
    for (int mi = 0; mi < 4; ++mi)
#pragma unroll
        for (int ni = 0; ni < 4; ++ni) acc[mi][ni] = (f32x4){0.f, 0.f, 0.f, 0.f};
    bf16x8 af[4][4], bfr[4][4];
#pragma unroll
    for (int ks = 0; ks < 4; ++ks)
#pragma unroll
        for (int i = 0; i < 4; ++i) { af[ks][i] = *(const GAS bf16x8*)(ap + (size_t)(16 * i) * D + 32 * ks); bfr[ks][i] = *(const GAS bf16x8*)(bp + (size_t)(16 * i) * D + 32 * ks); }
#pragma unroll
    for (int ks = 0; ks < 4; ++ks)
#pragma unroll
        for (int mi = 0; mi < 4; ++mi)
#pragma unroll
            for (int ni = 0; ni < 4; ++ni) acc[mi][ni] = __builtin_amdgcn_mfma_f32_16x16x32_bf16(bfr[ks][ni], af[ks][mi], acc[mi][ni], 0, 0, 0);
    LAS float* part = (LAS float*)(F.lds + RING_OFF) + w * (64 * ST_PITCH);
#pragma unroll
    for (int mi = 0; mi < 4; ++mi)
#pragma unroll
        for (int ni = 0; ni < 4; ++ni) *(LAS f32x4*)(part + (16 * mi + l15) * ST_PITCH + 16 * ni + 4 * lq) = acc[mi][ni];
    __syncthreads();
    const int r = 8 * w + (lane >> 3), c0 = 8 * (lane & 7);
    f32x4 s0 = (f32x4){0.f, 0.f, 0.f, 0.f}, s1 = s0;
#pragma unroll
    for (int ww = 0; ww < 8; ++ww) { const LAS float* p = (const LAS float*)(F.lds + RING_OFF) + ww * (64 * ST_PITCH) + r * ST_PITCH + c0; s0 += *(const LAS f32x4*)p; s1 += *(const LAS f32x4*)(p + 4); }
    const int slot0 = tn * 64 + c0, oc0 = (slot0 & ~255) + 64 * ((slot0 >> 5) & 3) + 32 * ((slot0 >> 7) & 1) + (slot0 & 31);
    const size_t row = (size_t)MP + tm * 64 + r; const size_t off = row * D + oc0;
    if (MODE == 0) {
        const v4u x = *(const GAS v4u*)(((const bf16*)(F.ws + WS_XB)) + off);
        v4u o; o.x = pk2(bflo(x.x) + s0.x, bfhi(x.x) + s0.y); o.y = pk2(bflo(x.y) + s0.z, bfhi(x.y) + s0.w); o.z = pk2(bflo(x.z) + s1.x, bfhi(x.z) + s1.y); o.w = pk2(bflo(x.w) + s1.z, bfhi(x.w) + s1.w);
        *(GAS v4u*)(((bf16*)(F.ws + WS_HB)) + off) = o;
    } else {
        const v4u h = *(const GAS v4u*)(((const bf16*)(F.ws + WS_HB)) + off), e = *(const GAS v4u*)(((const bf16*)(F.ws + WS_ERAW)) + off);
        const float re = ((const float*)(F.ws + WS_RSTDE))[row]; const float* gp = inp(17) + oc0; const f32x4 g0 = *(const f32x4*)gp, g1 = *(const f32x4*)(gp + 4);
        f32x4 y0, y1;
        y0.x = bflo(h.x) + fast_sigmoid(s0.x) * (bflo(e.x) * re * g0.x); y0.y = bfhi(h.x) + fast_sigmoid(s0.y) * (bfhi(e.x) * re * g0.y); y0.z = bflo(h.y) + fast_sigmoid(s0.z) * (bflo(e.y) * re * g0.z); y0.w = bfhi(h.y) + fast_sigmoid(s0.w) * (bfhi(e.y) * re * g0.w);
        y1.x = bflo(h.z) + fast_sigmoid(s1.x) * (bflo(e.z) * re * g1.x); y1.y = bfhi(h.z) + fast_sigmoid(s1.y) * (bfhi(e.z) * re * g1.y); y1.z = bflo(h.w) + fast_sigmoid(s1.z) * (bflo(e.w) * re * g1.z); y1.w = bfhi(h.w) + fast_sigmoid(s1.w) * (bfhi(e.w) * re * g1.w);
        float* yo = F.out + OUT_Y + off; *(f32x4*)yo = y0; *(f32x4*)(yo + 4) = y1;
    }
    __syncthreads();
}

struct Args { const float* in[19]; float* out; unsigned char* ws; int ph_lo, ph_hi, qlo, qhi; };
__global__ void __launch_bounds__(NWAVES * 64, 2) hymba_fwd(Args args) {
    extern __shared__ __attribute__((aligned(16))) unsigned char lds[];
    Frame F;
    F.lds = (LAS unsigned char*)lds;
    F.MISC = (volatile LAS unsigned*)(F.lds + MISC_OFF);
    F.wave = __builtin_amdgcn_readfirstlane((int)threadIdx.x >> 6);
    F.G = gridDim.x; { const int bx = blockIdx.x; F.vcu = (F.G % 8 == 0) ? (bx % 8) * (F.G / 8) + bx / 8 : bx; }
    unsigned char* ws = args.ws;
    F.ctl = (gu32*)(ws + WS_CTL); F.ws = ws;
    F.out = args.out;
    for (int u = (int)threadIdx.x; u < (LDS_BYTES - LDSCTL_OFF) / 4; u += NWAVES * 64) ((LAS unsigned*)(F.lds + LDSCTL_OFF))[u] = 0u;
    __syncthreads();
    XcdBarrier bar; bar.wave = F.wave; bar.bar = (unsigned*)(F.ctl + CW_BAR); bar.x = 0; bar.st = nullptr;
    if (N_LAUNCHES != PER_PHASE) bar = xcd_barrier_post((unsigned*)(F.ctl + CW_BAR), F.MISC + 8);
#define GRID_BAR(seam) do { if (N_LAUNCHES == PER_PHASE) { if (F.wave == 0 && lane_id() == 0) __hip_atomic_store(F.ctl + CW_TMO, 0xBADBA0u | (unsigned)(seam), RLX_AGENT); } else { xcd_barrier(bar); } } while (0)
    const int lo = args.ph_lo, hi = args.ph_hi;
#define IN(k) (lo <= (k) && (k) < hi)
#define BOTH(k) (IN(k) && IN((k) + 1))
    const int gw = F.vcu * NWAVES + F.wave, NGW = F.G * NWAVES;

    if (IN(0)) { p0_prologue(F); if (BOTH(0)) GRID_BAR(0); }

    if (IN(1)) {
        { pg8::Gemm g{((bf16*)(F.ws + WS_XB)), ((bf16*)(F.ws + WS_WIN)), M, DIN, D}; pg8::StaticOrder S; S.init(M, DIN, F.G, (int)blockIdx.x);
          pg8::EpiInProj E{((float*)(F.ws + WS_RSTD)), ((bf16*)(F.ws + WS_SEG)), SEG_BYTES / 2, F.out + OUT_KWIN, F.out + OUT_VWIN, F.out + OUT_KNEW, F.out + OUT_VNEW, inp(12), inp(13), MP, F.lds + pg8::STG_OFF};
          pg8::gemm_phase<pg8::EpiInProj, pg8::StaticOrder, true, true>(F.lds + RING_OFF, g, S, E, F.wave); }
        { int kple = DPLE; asm volatile("" : "+s"(kple));
          pg8::Gemm g{((bf16*)(F.ws + WS_PB)), ((bf16*)(F.ws + WS_WPLE)), M, D, kple}; pg8::FillOrder S; S.init(M, D, F.G, (int)blockIdx.x, (M / 256) * (DIN / 256));
          pg8::EpiPle E{((bf16*)(F.ws + WS_ERAW)), ((float*)(F.ws + WS_ESS)), F.lds + pg8::STG_OFF};
          pg8::gemm_phase<pg8::EpiPle, pg8::FillOrder, true, true>(F.lds + RING_OFF, g, S, E, F.wave); }
        if (BOTH(1)) GRID_BAR(1);
    }

    if (IN(2)) {
        for (int m = gw * 64 + lane_id(); m < M; m += NGW * 64) { const f32x4* e = (const f32x4*)(((float*)(F.ws + WS_ESS)) + (size_t)m * 16); const f32x4 a = e[0], b = e[1], c = e[2], d = e[3];
            const float ss = ((a.x + a.y) + (a.z + a.w)) + ((b.x + b.y) + (b.z + b.w)) + ((c.x + c.y) + (c.z + c.w)) + ((d.x + d.y) + (d.z + d.w));
            ((float*)(F.ws + WS_RSTDE))[m] = 1.0f / sqrtf(ss * (1.0f / D) + RMS_EPS); }
        constexpr int NU_S = NBS, NU_T = NBP * NH * 6, NU_G = MP / 128, NU_g = NBS * NGRP / NWAVES, NU = NU_S + NU_T + NU_G + NU_g;
        unsigned tk = 0u; const bool t0 = (F.wave == 0) && (lane_id() == 0);
        if (t0) tk = __hip_atomic_fetch_add(F.ctl + CW_QHEAD, 1u, RLX_AGENT);
        for (;;) {
            __syncthreads();
            if (t0) F.MISC[16] = tk;
            __syncthreads();
            int u = (int)F.MISC[16] + args.qlo;
            if (u >= NU || u >= args.qhi) break;
            if (t0) tk = __hip_atomic_fetch_add(F.ctl + CW_QHEAD, 1u, RLX_AGENT);
            if (u < NU_S) { samp_unit(F, u); continue; } u -= NU_S;
            if (u < NU_T) { const int type = u >> 8, rem = u & 255, bh = rem & 127; tj_unit(F, bh >> 3, bh & 7, type, rem >> 7); continue; } u -= NU_T;
            if (u < NU_G) { gmlp_batch(F, u * 128); continue; } u -= NU_G;
            { const int task = u * NWAVES + F.wave; gmlp_sample_task(F, task >> 2, task & 3); }
        }
        if (BOTH(2)) GRID_BAR(2);
    }

    if (IN(3)) {
        attn_finish_pass(F, gw, NGW);
        if (BOTH(3)) GRID_BAR(3);
    }

    if (IN(4)) {
        for (int t = F.vcu; t < 256; t += F.G) small_tile<0>(F, t, (const bf16*)(F.ws + WS_MIX), (const bf16*)(F.ws + WS_WOUT));
        pg8::Gemm g{((bf16*)(F.ws + WS_MIX)), ((bf16*)(F.ws + WS_WOUT)), MP, D, D}; pg8::StaticOrder S; S.init(MP, D, F.G, (int)blockIdx.x);
        pg8::EpiOut E{((bf16*)(F.ws + WS_XB)), ((bf16*)(F.ws + WS_HB)), F.lds + pg8::STG_OFF};
        pg8::gemm_phase<pg8::EpiOut, pg8::StaticOrder, true, true>(F.lds + RING_OFF, g, S, E, F.wave);
        if (BOTH(4)) GRID_BAR(4);
    }

    if (IN(5)) {
        for (int t = F.vcu; t < 256; t += F.G) small_tile<1>(F, t, (const bf16*)(F.ws + WS_HB), (const bf16*)(F.ws + WS_WG));
        pg8::Gemm g{((bf16*)(F.ws + WS_HB)), ((bf16*)(F.ws + WS_WG)), MP, D, D}; pg8::StaticOrder S; S.init(MP, D, F.G, (int)blockIdx.x);
        pg8::EpiGate E{F.out + OUT_Y, ((bf16*)(F.ws + WS_HB)), ((bf16*)(F.ws + WS_ERAW)), ((float*)(F.ws + WS_RSTDE)), inp(17), F.lds + pg8::STG_OFF};
        pg8::gemm_phase<pg8::EpiGate, pg8::StaticOrder, true, true>(F.lds + RING_OFF, g, S, E, F.wave);
    }
#undef IN
#undef BOTH
#undef GRID_BAR
}

extern "C" void kernel_launch(void* const* d_in, const int* in_sizes, int n_in, void* d_out, int out_size, void* d_ws, size_t ws_size, hipStream_t stream) {
    static int grid = 0;
    if (grid == 0) {
        if (n_in != 19 || in_sizes[0] != MP * D || (size_t)out_size != OUT_END || ws_size < WS_END) { fprintf(stderr, "kernel_launch: unexpected shapes (n_in %d, in0 %d, out %d, ws %zu); nothing launched\n", n_in, n_in > 0 ? in_sizes[0] : -1, out_size, ws_size); grid = -1; return; }
        int dev = 0, cus = 0, per_cu = 0;
        if (hipGetDevice(&dev) != hipSuccess || hipDeviceGetAttribute(&cus, hipDeviceAttributeMultiprocessorCount, dev) != hipSuccess) { fprintf(stderr, "kernel_launch: device query failed\n"); grid = -1; return; }
        if (hipFuncSetAttribute((const void*)hymba_fwd, hipFuncAttributeMaxDynamicSharedMemorySize, LDS_BYTES) != hipSuccess) { fprintf(stderr, "kernel_launch: hipFuncSetAttribute failed\n"); grid = -1; return; }
        if (hipOccupancyMaxActiveBlocksPerMultiprocessor(&per_cu, (const void*)hymba_fwd, NWAVES * 64, LDS_BYTES) != hipSuccess || per_cu < 1)
            fprintf(stderr, "kernel_launch: note: occupancy query reports %d workgroups per CU\n", per_cu);
        (void)hipGetLastError();
        grid = cus;
    }
    if (grid < 0) return;
    if (hipMemsetAsync((char*)d_ws + WS_CTL, 0, CTL_ZERO_BYTES, stream) != hipSuccess) { fprintf(stderr, "kernel_launch: memset failed\n"); return; }
    Args a{};
    for (int i = 0; i < 19; ++i) a.in[i] = (const float*)d_in[i];
    a.out = (float*)d_out; a.ws = (unsigned char*)d_ws;
    static_assert(N_LAUNCHES == 1 || N_LAUNCHES == PER_PHASE, "MK_N_LAUNCHES is 1 or 6");
#ifndef PROBE_DUP
#define PROBE_DUP -1
#endif
#ifndef PROBE_QLO
#define PROBE_QLO 0
#endif
#ifndef PROBE_QHI
#define PROBE_QHI (1 << 30)
#endif
    for (int li = 0; li < N_LAUNCHES; ++li) {
        a.ph_lo = (N_LAUNCHES == PER_PHASE) ? li : 0; a.ph_hi = (N_LAUNCHES == PER_PHASE) ? li + 1 : PER_PHASE; a.qlo = 0; a.qhi = 1 << 30;
        const int reps = (N_LAUNCHES == PER_PHASE && PROBE_DUP == li && li < 4) ? 2 : 1;
        for (int rp = 0; rp < reps; ++rp) {
            if (rp == 1 && li == 2) { (void)hipMemsetAsync((char*)d_ws + WS_CTL + 4 * CW_QHEAD, 0, 16, stream); a.qlo = PROBE_QLO; a.qhi = PROBE_QHI; }
            hipLaunchKernelGGL(hymba_fwd, dim3(grid), dim3(NWAVES * 64), LDS_BYTES, stream, a);
            const hipError_t le = hipPeekAtLastError();
            if (le != hipSuccess) { fprintf(stderr, "kernel_launch: launch %d failed: %s\n", li, hipGetErrorName(le)); break; }
        }
    }
    if (N_LAUNCHES == PER_PHASE && PROBE_DUP == 4) for (int li = 4; li < 6; ++li) { a.ph_lo = li; a.ph_hi = li + 1; hipLaunchKernelGGL(hymba_fwd, dim3(grid), dim3(NWAVES * 64), LDS_BYTES, stream, a); }
}
```

```cpp
#include <hip/hip_runtime.h>
#include <cstdio>
#include <cstdint>
#ifndef MK_N_LAUNCHES
#define MK_N_LAUNCHES 1
#endif
namespace pg8 {
#define PG8_LAS __attribute__((address_space(3)))
typedef unsigned short bf16_t;
typedef short bf16x8 __attribute__((ext_vector_type(8)));
typedef float f32x4 __attribute__((ext_vector_type(4)));
typedef unsigned u32x4 __attribute__((ext_vector_type(4)));
constexpr int BM = 256, BK = 64, HALF = 128, HTB = HALF * BK * 2  , STAGE_BYTES = 8 * HTB, NXCD = 8, WGM = 8;

__host__ __device__ __forceinline__ int lds_byte(int r, int c) { const int st = (r >> 4) * 2 + (c >> 5), rr = r & 15, cc = c & 31, ob = rr * 64 + cc * 2; return st * 1024 + (ob ^ (((ob >> 9) & 1) << 5)); }
__host__ __device__ __forceinline__ void stage_rc(int b, int& R, int& C) { const int st = b / 1024, sb = b % 1024, swz = sb ^ (((sb >> 9) & 1) << 5); R = (st >> 1) * 16 + swz / 64; C = (st & 1) * 32 + (swz % 64) / 2; }
__host__ __device__ __forceinline__ int perm32(int rho) { const int n = rho >> 4, i = rho & 15; return 8 * (i >> 2) + 4 * n + (i & 3); }

struct Unit { int pm, pn; };
struct Gemm { const bf16_t* A; const bf16_t* Bt; int M, N, K; };

struct StaticOrder {
    int nM, nN, nwg, G, c;
    __host__ __device__ void init(int M, int N, int G_, int c_) { nM = M / BM; nN = N / BM; nwg = nM * nN; G = G_; c = c_; }
    __host__ __device__ bool next(int i, Unit& u) const {
        const long L = (long)i * G + c; if (L >= nwg) return false;
        int wgid = (int)L; { const int q = nwg / NXCD, r = nwg % NXCD, xcd = wgid % NXCD, off = wgid / NXCD; wgid = (xcd < r ? xcd * (q + 1) : r * (q + 1) + (xcd - r) * q) + off; }
        const int nig = WGM * nN, gid = wgid / nig, fm = gid * WGM, gsz = (nM - fm) < WGM ? (nM - fm) : WGM;
        u.pm = fm + ((wgid % nig) % gsz); u.pn = (wgid % nig) / gsz; return true;
    }
    __device__ __forceinline__ void a_ready(const Unit&) const {}
    __device__ __forceinline__ void done(const Unit&) const {}
};
template <class Epi, class Sched, bool ALIGN_EPI = false, bool SP2 = false>
__device__ __forceinline__ void gemm_phase(PG8_LAS unsigned char* lds, const Gemm g, const Sched& S, const Epi& E, const int wid  ) {
    const int lane = (int)__builtin_amdgcn_mbcnt_hi(~0u, __builtin_amdgcn_mbcnt_lo(~0u, 0u)), tid = wid * 64 + lane, wr = wid >> 2, wc = wid & 3, fr = lane & 15, fq = lane >> 4;
    const int K = g.K, nt = K / BK;
    unsigned voffA[2], voffB[2];
#pragma unroll
    for (int i = 0; i < 2; ++i) { int R, C; stage_rc(tid * 16 + i * 8192, R, C); const int Rb = Epi::PERM ? ((R & ~31) + perm32(R & 31)) : R;
        voffA[i] = (unsigned)(R * K + C) * 2u; voffB[i] = (unsigned)(Rb * K + C) * 2u; }
    const size_t kstep = (size_t)(BK * 2);
    const size_t hstep = (size_t)HALF * K * 2;
    const size_t tstep = 2 * hstep;
    const unsigned ldsw = (unsigned)wid * 1024u;
    const int aoff = lds_byte(wr * 64 + fr, fq * 8), boff = lds_byte(wc * 32 + fr, fq * 8);
#define PG8_SA(b, h) (((b) * 2 + (h)) * HTB)
#define PG8_SB(b, h) ((4 + (b) * 2 + (h)) * HTB)
#define PG8_STAGE(bufoff, gbase, voff) do { _Pragma("unroll") for (int _i = 0; _i < 2; ++_i) \
        __builtin_amdgcn_global_load_lds((const unsigned*)((const char*)(gbase) + (voff)[_i]), (PG8_LAS unsigned*)(lds + (bufoff) + ldsw + _i * 8192), 16, 0, 0); } while (0)
#define PG8_LDA(dst, b, h) do { _Pragma("unroll") for (int m = 0; m < 4; ++m) _Pragma("unroll") for (int k = 0; k < 2; ++k) dst[m][k] = *(const PG8_LAS bf16x8*)(lds + PG8_SA(b, h) + aoff + m * 2048 + k * 1024); } while (0)
#define PG8_LDB(dst, b, h) do { _Pragma("unroll") for (int n = 0; n < 2; ++n) _Pragma("unroll") for (int k = 0; k < 2; ++k) dst[n][k] = *(const PG8_LAS bf16x8*)(lds + PG8_SB(b, h) + boff + n * 2048 + k * 1024); } while (0)
#define PG8_MMA(ai, bj, At, Bt) do { __builtin_amdgcn_s_setprio(1); _Pragma("unroll") for (int m = 0; m < 4; ++m) _Pragma("unroll") for (int n = 0; n < 2; ++n) _Pragma("unroll") for (int k = 0; k < 2; ++k) \
        acc[ai][bj][m][n] = __builtin_amdgcn_mfma_f32_16x16x32_bf16(Bt[n][k], At[m][k], acc[ai][bj][m][n], 0, 0, 0); __builtin_amdgcn_s_setprio(0); } while (0)
#define PG8_WAIT_V(n) asm volatile("s_waitcnt vmcnt(" #n ")" ::: "memory")
#define PG8_WAIT_L(n) asm volatile("s_waitcnt lgkmcnt(" #n ")" ::: "memory")
#define PG8_BAR __builtin_amdgcn_s_barrier()
#define PG8_SCHED __builtin_amdgcn_sched_barrier(0)
    Unit cur, nxt; int ui = 0;
    if (!S.next(0, cur)) return;
    f32x4 acc[2][2][4][2];
#pragma unroll
    for (int a = 0; a < 2; ++a)
#pragma unroll
        for (int b = 0; b < 2; ++b)
#pragma unroll
            for (int m = 0; m < 4; ++m)
#pragma unroll
                for (int n = 0; n < 2; ++n) acc[a][b][m][n] = (f32x4){0.f, 0.f, 0.f, 0.f};
    bf16x8 At[4][2], B0[2][2], B1[2][2];
    const char* cA = (const char*)g.A + (size_t)cur.pm * tstep; const char* cB = (const char*)g.Bt + (size_t)cur.pn * tstep;
    S.a_ready(cur);
    if constexpr (SP2) {
        PG8_STAGE(PG8_SB(0, 0), cB, voffB); PG8_STAGE(PG8_SB(0, 1), cB + hstep, voffB); PG8_STAGE(PG8_SA(0, 0), cA, voffA); PG8_STAGE(PG8_SA(0, 1), cA + hstep, voffA);
        if (wr == 1) PG8_BAR;
        PG8_WAIT_V(2); PG8_BAR;
        PG8_STAGE(PG8_SB(1, 0), cB + kstep, voffB); PG8_STAGE(PG8_SA(1, 0), cA + kstep, voffA); PG8_STAGE(PG8_SB(1, 1), cB + hstep + kstep, voffB);
        PG8_WAIT_V(6); PG8_BAR;
    } else {
        PG8_STAGE(PG8_SB(0, 0), cB, voffB); PG8_STAGE(PG8_SA(0, 0), cA, voffA); PG8_STAGE(PG8_SB(0, 1), cB + hstep, voffB); PG8_STAGE(PG8_SA(0, 1), cA + hstep, voffA);
        if (wr == 1) PG8_BAR;
        PG8_WAIT_V(4); PG8_BAR;
        PG8_STAGE(PG8_SB(1, 0), cB + kstep, voffB); PG8_STAGE(PG8_SA(1, 0), cA + kstep, voffA); PG8_STAGE(PG8_SB(1, 1), cB + hstep + kstep, voffB);
        PG8_WAIT_V(6); PG8_BAR;
    }
    for (;;) {
        const bool has_next = S.next(ui + 1, nxt);
        const char* nA = has_next ? (const char*)g.A + (size_t)nxt.pm * tstep : cA; const char* nB = has_next ? (const char*)g.Bt + (size_t)nxt.pn * tstep : cB;
        for (int t = 0; t < nt; t += 2) {
            const bool last = (t == nt - 2);
            const char* a1 = cA + (size_t)(t + 1) * kstep;
            const char* a2 = last ? nA : cA + (size_t)(t + 2) * kstep; const char* b2 = last ? nB : cB + (size_t)(t + 2) * kstep;
            const char* a3 = a2 + kstep; const char* b3 = b2 + kstep;
            if (last && has_next) S.a_ready(nxt);
            if constexpr (SP2) {
            PG8_LDB(B0, 0, 0); PG8_LDB(B1, 0, 1); PG8_SCHED; PG8_LDA(At, 0, 0); PG8_STAGE(PG8_SA(1, 1), a1 + hstep, voffA);
            PG8_WAIT_V(8); PG8_WAIT_L(0); PG8_BAR; PG8_MMA(0, 0, At, B0); PG8_MMA(0, 1, At, B1); PG8_BAR; PG8_SCHED;
            PG8_LDA(At, 0, 1); PG8_STAGE(PG8_SB(0, 0), b2, voffB); PG8_STAGE(PG8_SB(0, 1), b2 + hstep, voffB); PG8_STAGE(PG8_SA(0, 0), a2, voffA);
            PG8_WAIT_V(8); PG8_WAIT_L(0); PG8_BAR; PG8_MMA(1, 0, At, B0); PG8_MMA(1, 1, At, B1); PG8_BAR; PG8_SCHED;
            PG8_LDB(B0, 1, 0); PG8_LDB(B1, 1, 1); PG8_SCHED; PG8_LDA(At, 1, 0); PG8_STAGE(PG8_SA(0, 1), a2 + hstep, voffA);
            PG8_WAIT_V(8); PG8_WAIT_L(0); PG8_BAR; PG8_MMA(0, 0, At, B0); PG8_MMA(0, 1, At, B1); PG8_BAR; PG8_SCHED;
            PG8_LDA(At, 1, 1); PG8_STAGE(PG8_SB(1, 0), b3, voffB); PG8_STAGE(PG8_SB(1, 1), b3 + hstep, voffB); PG8_STAGE(PG8_SA(1, 0), a3, voffA);
            PG8_WAIT_V(8); PG8_WAIT_L(0); PG8_BAR; PG8_MMA(1, 0, At, B0); PG8_MMA(1, 1, At, B1); PG8_BAR; PG8_SCHED;
            } else {
            PG8_LDB(B0, 0, 0); PG8_SCHED; PG8_LDA(At, 0, 0); PG8_STAGE(PG8_SA(1, 1), a1 + hstep, voffA);
            PG8_WAIT_L(8); PG8_BAR; PG8_WAIT_L(0); PG8_MMA(0, 0, At, B0); PG8_BAR; PG8_SCHED;
            PG8_LDB(B1, 0, 1); PG8_STAGE(PG8_SB(0, 0), b2, voffB);
            PG8_BAR; PG8_WAIT_L(0); PG8_MMA(0, 1, At, B1); PG8_BAR;
            PG8_LDA(At, 0, 1); PG8_STAGE(PG8_SA(0, 0), a2, voffA);
            PG8_BAR; PG8_WAIT_L(0); PG8_MMA(1, 0, At, B0); PG8_BAR; PG8_SCHED;
            PG8_STAGE(PG8_SB(0, 1), b2 + hstep, voffB);
            PG8_WAIT_V(6); PG8_BAR; PG8_MMA(1, 1, At, B1); PG8_BAR;
            PG8_LDB(B0, 1, 0); PG8_SCHED; PG8_LDA(At, 1, 0); PG8_STAGE(PG8_SA(0, 1), a2 + hstep, voffA);
            PG8_WAIT_L(8); PG8_BAR; PG8_WAIT_L(0); PG8_MMA(0, 0, At, B0); PG8_BAR; PG8_SCHED;
            PG8_LDB(B1, 1, 1); PG8_STAGE(PG8_SB(1, 0), b3, voffB);
            PG8_BAR; PG8_WAIT_L(0); PG8_MMA(0, 1, At, B1); PG8_BAR;
            PG8_LDA(At, 1, 1); PG8_STAGE(PG8_SA(1, 0), a3, voffA);
            PG8_BAR; PG8_WAIT_L(0); PG8_MMA(1, 0, At, B0); PG8_BAR; PG8_SCHED;
            PG8_STAGE(PG8_SB(1, 1), b3 + hstep, voffB);
            PG8_WAIT_V(6); PG8_BAR; PG8_MMA(1, 1, At, B1); PG8_BAR;
            }
        }
        if constexpr (ALIGN_EPI) { if (wr == 0) PG8_BAR; }
        if constexpr (!Epi::AFTER_DRAIN) { E(acc, cur, wr, wc, fr, fq); S.done(cur); }
        if (!has_next) break;
#pragma unroll
        for (int a = 0; a < 2; ++a)
#pragma unroll
            for (int b = 0; b < 2; ++b)
#pragma unroll
                for (int m = 0; m < 4; ++m)
#pragma unroll
                    for (int n = 0; n < 2; ++n) acc[a][b][m][n] = (f32x4){0.f, 0.f, 0.f, 0.f};
        cur = nxt; cA = nA; cB = nB; ++ui;
        if constexpr (ALIGN_EPI) { if (wr == 1) PG8_BAR; }
    }
    PG8_WAIT_V(0);
    if constexpr (!ALIGN_EPI) { if (wr == 0) PG8_BAR; }
    PG8_BAR;
    if constexpr (Epi::AFTER_DRAIN) { E.fused(acc, cur, wr, wc, fr, fq, lds, wid, lane); S.done(cur); }
#undef PG8_SA
#undef PG8_SB
#undef PG8_STAGE
#undef PG8_LDA
#undef PG8_LDB
#undef PG8_MMA
#undef PG8_WAIT_V
#undef PG8_WAIT_L
#undef PG8_BAR
#undef PG8_SCHED
}
}
namespace pg8 {
typedef float f32x2_t __attribute__((ext_vector_type(2)));
typedef __bf16 bf16x2_t __attribute__((ext_vector_type(2)));
typedef unsigned u32x2 __attribute__((ext_vector_type(2)));
__device__ __forceinline__ unsigned pk2(float lo, float hi) { f32x2_t v = {lo, hi}; bf16x2_t b = __builtin_convertvector(v, bf16x2_t); return __builtin_bit_cast(unsigned, b); }
__device__ __forceinline__ float bflo(unsigned u) { return __uint_as_float(u << 16); }
__device__ __forceinline__ float bfhi(unsigned u) { return __uint_as_float(u & 0xffff0000u); }
__device__ __forceinline__ float fast_sigmoid(float v) { return __builtin_amdgcn_rcpf(1.0f + __builtin_amdgcn_exp2f(-1.4426950408889634f * v)); }
constexpr float RMS_EPS = 1e-6f;
constexpr float QSCALE = 0.125f * 1.4426950408889634f;

constexpr int STG_OFF = 131072, STG_WAVE = 16 * 144;
template <bool NT = true> __device__ __forceinline__ void stage_store_128(PG8_LAS unsigned char* sw, int fr, int lane, int o0, const u32x4 v0, int o1, const u32x4 v1, unsigned char* g0, size_t pitch) {
    *(PG8_LAS u32x4*)(sw + fr * 144 + o0) = v0; *(PG8_LAS u32x4*)(sw + fr * 144 + o1) = v1;
#pragma unroll
    for (int i = 0; i < 2; ++i) { const int row = 8 * i + (lane >> 3), ch = lane & 7; const u32x4 t = *(const PG8_LAS u32x4*)(sw + row * 144 + 16 * ch); if (NT) __builtin_nontemporal_store(t, (u32x4*)(g0 + (size_t)row * pitch + 16 * ch)); else *(u32x4*)(g0 + (size_t)row * pitch + 16 * ch) = t; }
}
struct EpiInProj {
    static constexpr bool PERM = true, AFTER_DRAIN = false;
    const float* rstd; bf16_t* seg0; size_t seg_stride; float *kwin, *vwin, *knew, *vnew; const float *gq, *gk; int mp; PG8_LAS unsigned char* stg;
    __device__ __forceinline__ void operator()(const f32x4 (&acc)[2][2][4][2], const Unit& u, int wr, int wc, int fr, int fq) const {
        asm volatile("" : "+v"(fr), "+v"(fq));
        const int sg = u.pn >> 1;
        const int col0 = (u.pn & 1) * 256 + wc * 64 + 8 * fq;
        const int row0 = u.pm * BM + wr * 64 + fr;
        bf16_t* ob = seg0 + (size_t)sg * seg_stride;
        const bool prompt = row0 < mp;
        float* fo = nullptr;
        if (sg == 4) fo = prompt ? kwin : knew;
        if (sg == 5) fo = prompt ? vwin : vnew;
        const int frow0 = prompt ? row0 : row0 - mp;
        const bool do_norm = (sg == 3) || (sg == 4), do_silu = (sg == 2) || (sg == 6);
        f32x4 gn[2][2];
#pragma unroll
        for (int bj = 0; bj < 2; ++bj)
#pragma unroll
            for (int n = 0; n < 2; ++n) gn[bj][n] = (f32x4){1.f, 1.f, 1.f, 1.f};
        if (do_norm) { const float* g = (sg == 3) ? gq : gk; const float sc = (sg == 3) ? QSCALE : 1.0f;
#pragma unroll
            for (int bj = 0; bj < 2; ++bj)
#pragma unroll
                for (int n = 0; n < 2; ++n) gn[bj][n] = *(const f32x4*)(g + 32 * bj + 8 * fq + 4 * n) * sc; }
        float rsv[2][4];
#pragma unroll
        for (int m = 0; m < 4; ++m) rsv[0][m] = rstd[row0 + m * 16];
#pragma unroll
        for (int ai = 0; ai < 2; ++ai) {
#pragma unroll
            for (int m = 0; m < 4; ++m) {
                if (ai == 0 && m == 1) {
#pragma unroll
                    for (int mm = 0; mm < 4; ++mm) rsv[1][mm] = rstd[row0 + HALF + mm * 16];
                }
                const int r = row0 + ai * HALF + m * 16;
                const float rs = rsv[ai][m];
                f32x4 v[2][2];
#pragma unroll
                for (int bj = 0; bj < 2; ++bj)
#pragma unroll
                    for (int n = 0; n < 2; ++n) v[bj][n] = acc[ai][bj][m][n] * rs;
                if (do_norm) {
                    float ss = 0.f;
#pragma unroll
                    for (int bj = 0; bj < 2; ++bj)
#pragma unroll
                        for (int n = 0; n < 2; ++n) { const f32x4 x = v[bj][n]; ss += (x[0] * x[0] + x[1] * x[1]) + (x[2] * x[2] + x[3] * x[3]); }
                    ss += __shfl_xor(ss, 16); ss += __shfl_xor(ss, 32);
                    const float rn = 1.0f / sqrtf(ss * (1.0f / 64.0f) + RMS_EPS);
#pragma unroll
                    for (int bj = 0; bj < 2; ++bj)
#pragma unroll
                        for (int n = 0; n < 2; ++n) v[bj][n] = v[bj][n] * rn * gn[bj][n];
                }
                if (do_silu) {
#pragma unroll
                    for (int bj = 0; bj < 2; ++bj)
#pragma unroll
                        for (int n = 0; n < 2; ++n)
#pragma unroll
                            for (int j = 0; j < 4; ++j) v[bj][n][j] = v[bj][n][j] * fast_sigmoid(v[bj][n][j]);
                }
                const int lane_ = fr + 16 * fq; PG8_LAS unsigned char* sw = stg + (wr * 4 + wc) * STG_WAVE;
                const int rb = u.pm * BM + wr * 64 + ai * HALF + m * 16, cb = (u.pn & 1) * 256 + wc * 64;
                { u32x4 w0, w1; w0.x = pk2(v[0][0][0], v[0][0][1]); w0.y = pk2(v[0][0][2], v[0][0][3]); w0.z = pk2(v[0][1][0], v[0][1][1]); w0.w = pk2(v[0][1][2], v[0][1][3]);
                  w1.x = pk2(v[1][0][0], v[1][0][1]); w1.y = pk2(v[1][0][2], v[1][0][3]); w1.z = pk2(v[1][1][0], v[1][1][1]); w1.w = pk2(v[1][1][2], v[1][1][3]);
                  if (sg >= 3 && sg <= 5) stage_store_128<false>(sw, fr, lane_, 16 * fq, w0, 64 + 16 * fq, w1, (unsigned char*)(ob + (size_t)rb * 512 + cb), 1024);
                  else stage_store_128<true>(sw, fr, lane_, 16 * fq, w0, 64 + 16 * fq, w1, (unsigned char*)(ob + (size_t)rb * 512 + cb), 1024); }
                if (fo) { float* f0 = fo + (size_t)(prompt ? rb : rb - mp) * 512 + cb;
#pragma unroll
                    for (int bj = 0; bj < 2; ++bj) stage_store_128(sw, fr, lane_, 32 * fq, __builtin_bit_cast(u32x4, v[bj][0]), 32 * fq + 16, __builtin_bit_cast(u32x4, v[bj][1]), (unsigned char*)(f0 + 32 * bj), 2048); }
            }
        }
    }
};
struct EpiPle {
    static constexpr bool PERM = true, AFTER_DRAIN = false;
    bf16_t* eraw; float* ess; PG8_LAS unsigned char* stg;
    __device__ __forceinline__ void operator()(const f32x4 (&acc)[2][2][4][2], const Unit& u, int wr, int wc, int fr, int fq) const {
        asm volatile("" : "+v"(fr), "+v"(fq));
        const int lane_ = fr + 16 * fq; PG8_LAS unsigned char* sw = stg + (wr * 4 + wc) * STG_WAVE;
        const int cb = u.pn * BM + wc * 64;
#pragma unroll
        for (int ai = 0; ai < 2; ++ai)
#pragma unroll
            for (int m = 0; m < 4; ++m) {
                const int rb = u.pm * BM + wr * 64 + ai * HALF + m * 16; float ss = 0.f; u32x4 w[2];
#pragma unroll
                for (int bj = 0; bj < 2; ++bj) { const f32x4 a = acc[ai][bj][m][0], b = acc[ai][bj][m][1];
                    ss += (a[0] * a[0] + a[1] * a[1]) + (a[2] * a[2] + a[3] * a[3]); ss += (b[0] * b[0] + b[1] * b[1]) + (b[2] * b[2] + b[3] * b[3]);
                    w[bj].x = pk2(a[0], a[1]); w[bj].y = pk2(a[2], a[3]); w[bj].z = pk2(b[0], b[1]); w[bj].w = pk2(b[2], b[3]); }
                stage_store_128(sw, fr, lane_, 16 * fq, w[0], 64 + 16 * fq, w[1], (unsigned char*)(eraw + (size_t)rb * 1024 + cb), 2048);
                ss += __shfl_xor(ss, 16); ss += __shfl_xor(ss, 32);
                if (fq == 0) ess[(size_t)(rb + fr) * 16 + u.pn * 4 + wc] = ss;
            }
    }
};
struct EpiOut {
    static constexpr bool PERM = true, AFTER_DRAIN = false;
    const bf16_t* xb; bf16_t* hb; PG8_LAS unsigned char* stg;
    __device__ __forceinline__ void operator()(const f32x4 (&acc)[2][2][4][2], const Unit& u, int wr, int wc, int fr, int fq) const {
        asm volatile("" : "+v"(fr), "+v"(fq));
        const int lane_ = fr + 16 * fq; PG8_LAS unsigned char* sw = stg + (wr * 4 + wc) * STG_WAVE;
        const int cb = u.pn * BM + wc * 64;
        constexpr int PD = 3;
        u32x4 xq[8][2];
#pragma unroll
        for (int it = 0; it < PD; ++it)
#pragma unroll
            for (int bj = 0; bj < 2; ++bj) xq[it][bj] = __builtin_nontemporal_load((const u32x4*)(xb + (size_t)(u.pm * BM + wr * 64 + (it >> 2) * HALF + (it & 3) * 16 + fr) * 1024 + cb + 8 * fq + 32 * bj));
#pragma unroll
        for (int it = 0; it < 8; ++it) {
            const int ai = it >> 2, m = it & 3;
            if (it + PD < 8) {
#pragma unroll
                for (int bj = 0; bj < 2; ++bj) xq[(it + PD) & 7][bj] = __builtin_nontemporal_load((const u32x4*)(xb + (size_t)(u.pm * BM + wr * 64 + ((it + PD) >> 2) * HALF + ((it + PD) & 3) * 16 + fr) * 1024 + cb + 8 * fq + 32 * bj));
            }
            const int rb = u.pm * BM + wr * 64 + ai * HALF + m * 16;
            u32x4 w[2];
#pragma unroll
            for (int bj = 0; bj < 2; ++bj) { const f32x4 a = acc[ai][bj][m][0], b = acc[ai][bj][m][1]; const u32x4 x = xq[it][bj];
                w[bj].x = pk2(bflo(x.x) + a[0], bfhi(x.x) + a[1]); w[bj].y = pk2(bflo(x.y) + a[2], bfhi(x.y) + a[3]); w[bj].z = pk2(bflo(x.z) + b[0], bfhi(x.z) + b[1]); w[bj].w = pk2(bflo(x.w) + b[2], bfhi(x.w) + b[3]); }
            stage_store_128<false>(sw, fr, lane_, 16 * fq, w[0], 64 + 16 * fq, w[1], (unsigned char*)(hb + (size_t)rb * 1024 + cb), 2048);
        }
    }
};
struct EpiGate {
    static constexpr bool PERM = true, AFTER_DRAIN = false;
    float* y; const bf16_t* hb; const bf16_t* eraw; const float* rstde; const float* gple; PG8_LAS unsigned char* stg;
    __device__ __forceinline__ void operator()(const f32x4 (&acc)[2][2][4][2], const Unit& u, int wr, int wc, int fr, int fq) const {
        asm volatile("" : "+v"(fr), "+v"(fq));
        const int lane_ = fr + 16 * fq; PG8_LAS unsigned char* sw = stg + (wr * 4 + wc) * STG_WAVE;
        const int cb = u.pn * BM + wc * 64;
        f32x4 gp[2][2];
#pragma unroll
        for (int bj = 0; bj < 2; ++bj)
#pragma unroll
            for (int n = 0; n < 2; ++n) gp[bj][n] = *(const f32x4*)(gple + cb + 32 * bj + 8 * fq + 4 * n);
        float rev[2][4];
#pragma unroll
        for (int ai = 0; ai < 2; ++ai)
#pragma unroll
            for (int m = 0; m < 4; ++m) rev[ai][m] = rstde[u.pm * BM + wr * 64 + ai * HALF + m * 16 + fr];
        constexpr int PD = 2;
        u32x4 eq[8][2], hq[8][2];
#pragma unroll
        for (int it = 0; it < PD; ++it)
#pragma unroll
            for (int bj = 0; bj < 2; ++bj) { const size_t o = (size_t)(u.pm * BM + wr * 64 + (it >> 2) * HALF + (it & 3) * 16 + fr) * 1024 + cb + 8 * fq + 32 * bj;
                eq[it][bj] = __builtin_nontemporal_load((const u32x4*)(eraw + o)); hq[it][bj] = *(const u32x4*)(hb + o); }
#pragma unroll
        for (int it = 0; it < 8; ++it) {
            const int ai = it >> 2, m = it & 3;
            if (it + PD < 8) {
#pragma unroll
                for (int bj = 0; bj < 2; ++bj) { const size_t o = (size_t)(u.pm * BM + wr * 64 + ((it + PD) >> 2) * HALF + ((it + PD) & 3) * 16 + fr) * 1024 + cb + 8 * fq + 32 * bj;
                    eq[(it + PD) & 7][bj] = __builtin_nontemporal_load((const u32x4*)(eraw + o)); hq[(it + PD) & 7][bj] = *(const u32x4*)(hb + o); }
            }
            const int rb = u.pm * BM + wr * 64 + ai * HALF + m * 16; const float re = rev[ai][m];
#pragma unroll
            for (int bj = 0; bj < 2; ++bj) {
                const u32x4 e = eq[it][bj], h = hq[it][bj];
                const f32x4 a = acc[ai][bj][m][0], b = acc[ai][bj][m][1];
                const f32x4 e0 = (f32x4){bflo(e.x), bfhi(e.x), bflo(e.y), bfhi(e.y)}, e1 = (f32x4){bflo(e.z), bfhi(e.z), bflo(e.w), bfhi(e.w)};
                const f32x4 h0 = (f32x4){bflo(h.x), bfhi(h.x), bflo(h.y), bfhi(h.y)}, h1 = (f32x4){bflo(h.z), bfhi(h.z), bflo(h.w), bfhi(h.w)};
                f32x4 s0, s1;
#pragma unroll
                for (int j = 0; j < 4; ++j) { s0[j] = fast_sigmoid(a[j]); s1[j] = fast_sigmoid(b[j]); }
                const f32x4 y0 = h0 + s0 * (e0 * re * gp[bj][0]), y1 = h1 + s1 * (e1 * re * gp[bj][1]);
                stage_store_128(sw, fr, lane_, 32 * fq, __builtin_bit_cast(u32x4, y0), 32 * fq + 16, __builtin_bit_cast(u32x4, y1), (unsigned char*)(y + (size_t)rb * 1024 + cb + 32 * bj), 4096); }
        }
    }
};
struct FillOrder {
    int nN, nwg, idx, nfree;
    __host__ __device__ void init(int M, int N, int G, int c, int nprev) { nN = N / BM; nwg = (M / BM) * nN; const int r = nprev % G; if (r == 0) { idx = c; nfree = G; } else { idx = c - r; nfree = G - r; } }
    __host__ __device__ bool next(int i, Unit& u) const { if (idx < 0) return false; const long L = (long)i * nfree + idx; if (L >= nwg) return false; u.pm = (int)(L / nN); u.pn = (int)(L % nN); return true; }
    __device__ __forceinline__ void a_ready(const Unit&) const {}
    __device__ __forceinline__ void done(const Unit&) const {}
};
}
constexpr int NWAVES = 8;
#ifndef MK_N_LAUNCHES
#define MK_N_LAUNCHES 1
#endif
constexpr int N_LAUNCHES = MK_N_LAUNCHES;
constexpr int PER_PHASE = 6;

constexpr int MP = 32768, MS = 1024, M = MP + MS;
constexpr int D = 1024, DIN = 3584, DSEG = 512, NH = 8, HD = 64, NGRP = 4, GA = 128, DPLE = 256, SEQ = 2048, NBP = 16, NBS = 128, TS = 8, WB = 2048;
constexpr size_t OUT_Y = 0, OUT_KWIN = (size_t)M * D, OUT_VWIN = OUT_KWIN + (size_t)MP * DSEG, OUT_KNEW = OUT_VWIN + (size_t)MP * DSEG, OUT_VNEW = OUT_KNEW + (size_t)MS * DSEG,
                 OUT_VACH = OUT_VNEW + (size_t)MS * DSEG, OUT_END = OUT_VACH + (size_t)MS * DSEG;
static_assert(OUT_END == 69730304, "output size");
using pg8::pk2; using pg8::bflo; using pg8::bfhi; using pg8::RMS_EPS; using pg8::fast_sigmoid;

constexpr size_t MiB = 1u << 20;
constexpr size_t WS_CTL = 0, CTL_ZERO_BYTES = 64 * 1024;
constexpr size_t WS_WIN = 2 * MiB, WS_WOUT = 10 * MiB, WS_WPLE = 12 * MiB, WS_WG = 13 * MiB, WS_WS = 15 * MiB;
constexpr size_t WS_RSTD = 15 * MiB + 512 * 1024, WS_RSTDE = 15 * MiB + 768 * 1024;
constexpr size_t WS_ESS = 16 * MiB;
constexpr size_t WS_PA = 20 * MiB, WS_PAL = 22 * MiB, WS_PBC = 23 * MiB, WS_PBCL = 39 * MiB;
constexpr size_t WS_XB = 40 * MiB, WS_PB = 106 * MiB, WS_SEG = 123 * MiB, SEG_BYTES = 33 * MiB;
constexpr size_t WS_MIX = 354 * MiB, WS_HB = 420 * MiB, WS_ERAW = 486 * MiB, WS_PO = 552 * MiB, WS_PL = 648 * MiB, WS_END = 652 * MiB;
static_assert((size_t)M * DSEG * 2 == SEG_BYTES && (size_t)M * D * 2 == 66 * MiB && (size_t)M * 16 * 4 <= 4 * MiB && (size_t)DIN * D * 2 <= 8 * MiB, "d_ws map");
enum Seg { SG_U = 0, SG_VA = 1, SG_ZA = 2, SG_Q = 3, SG_K = 4, SG_V = 5, SG_ZB = 6 };
constexpr int CW_TMO = 0, CW_CODE = 1, CW_QHEAD = 64, CW_BAR = 4096;

constexpr int RING_OFF = 0, RING_BYTES = 131072;
constexpr int LDSCTL_OFF = 147 * 1024, MISC_OFF = LDSCTL_OFF + 320;
constexpr int LDS_BYTES = 151552;
static_assert(MISC_OFF + 128 <= LDS_BYTES, "LDS map");

#define GAS __attribute__((address_space(1)))
#define LAS __attribute__((address_space(3)))
typedef unsigned short bf16;
typedef unsigned v4u __attribute__((ext_vector_type(4)));
typedef unsigned v2u __attribute__((ext_vector_type(2)));
typedef float f32x4 __attribute__((ext_vector_type(4)));
typedef float f32x16 __attribute__((ext_vector_type(16)));
typedef short bf16x8 __attribute__((ext_vector_type(8)));
typedef short s16x4 __attribute__((ext_vector_type(4)));
typedef GAS unsigned gu32;
#define RLX_AGENT __ATOMIC_RELAXED, __HIP_MEMORY_SCOPE_AGENT
#define LDS_WAIT() asm volatile("s_waitcnt lgkmcnt(0)" ::: "memory")
#define VM_WAIT() asm volatile("s_waitcnt vmcnt(0)" ::: "memory")
#define XB_TMO      128
#define XB_XCNT(j)  (256  + 64 * (j))
#define XB_XSUB(j)  (1280 + 64 * (j))
#define XB_XGEN(j)  (2304 + 64 * (j))
#define XB_TOP      3328
#define XB_TOPGEN   3392
#define XCD_BAR_WORDS 3456
#define XB_SPIN_CAP (1u << 18)

__device__ __forceinline__ unsigned xb_ld(unsigned* p)              { return __hip_atomic_load(p, __ATOMIC_RELAXED, __HIP_MEMORY_SCOPE_AGENT); }
__device__ __forceinline__ unsigned xb_add(unsigned* p, unsigned v) { return __hip_atomic_fetch_add(p, v, __ATOMIC_RELAXED, __HIP_MEMORY_SCOPE_AGENT); }
__device__ __forceinline__ unsigned xb_xcc_id() { return (unsigned)__builtin_amdgcn_s_getreg((3 << 11) | 20) & 0xFu; }
#define XB_SPIN(cond, bar) do { unsigned _sp = 0; while (cond) { __builtin_amdgcn_s_sleep(1); \
    if ((++_sp & 255u) == 0u) { if (xb_ld(&(bar)[XB_TMO])) break; if (_sp > XB_SPIN_CAP) { atomicAdd(&(bar)[XB_TMO], 1u); break; } } } } while (0)

struct XcdBarrier {
    int wave;
    unsigned* bar; unsigned x;
    volatile LAS unsigned* st;
};

__device__ __forceinline__ XcdBarrier xcd_barrier_post(unsigned* bar, volatile LAS unsigned* st) {
    XcdBarrier b; b.wave = (int)__builtin_amdgcn_readfirstlane((int)threadIdx.x >> 6); b.bar = bar; b.x = xb_xcc_id(); b.st = st;
    if (threadIdx.x == 0) (void)xb_add(&bar[XB_XCNT(b.x)], 1u);
    return b;
}
__device__ __forceinline__ void xcd_barrier_complete(unsigned* bar, unsigned x, unsigned& nloc, unsigned& nx) {
    const unsigned G = gridDim.x * gridDim.y * gridDim.z;
    unsigned sum, cnt, mine, sp = 0u;
    for (;;) {
        sum = 0u; cnt = 0u; mine = 0u;
#pragma unroll
        for (unsigned j = 0; j < 16; ++j) { const unsigned c = xb_ld(&bar[XB_XCNT(j)]); sum += c; cnt += (c > 0u) ? 1u : 0u; mine = (j == x) ? c : mine; }
        if (sum == G) break;
        __builtin_amdgcn_s_sleep(1);
        if ((++sp & 255u) == 0u) { if (xb_ld(&bar[XB_TMO])) break; if (sp > XB_SPIN_CAP) { atomicAdd(&bar[XB_TMO], 1u); break; } }
    }
    nloc = mine > 0u ? mine : 1u; nx = cnt > 0u ? cnt : 1u;
}

__device__ __forceinline__ void xcd_barrier(const XcdBarrier& b) {
    asm volatile("s_waitcnt vmcnt(0)" ::: "memory");
    __syncthreads();
    if (b.wave == 0 && __builtin_amdgcn_mbcnt_hi(~0u, __builtin_amdgcn_mbcnt_lo(~0u, 0u)) == 0u) {
        unsigned* bar = b.bar;
        __builtin_amdgcn_s_waitcnt(0);
        unsigned nloc = b.st[0], nx = b.st[1];
        if (nloc == 0u) { xcd_barrier_complete(bar, b.x, nloc, nx); b.st[0] = nloc; b.st[1] = nx; }
        const unsigned old = xb_add(&bar[XB_XSUB(b.x)], 1u);
        const unsigned gen = old / nloc;
        if (old + 1u == (gen + 1u) * nloc) {
            __builtin_amdgcn_fence(__ATOMIC_RELEASE, "agent");
            asm volatile("s_waitcnt vmcnt(0)" ::: "memory");
            const unsigned og = xb_add(&bar[XB_TOP], 1u);
            const unsigned tg = og / nx;
            if (og + 1u == (tg + 1u) * nx) xb_add(&bar[XB_TOPGEN], 1u);
            else XB_SPIN(xb_ld(&bar[XB_TOPGEN]) == tg, bar);
            __builtin_amdgcn_fence(__ATOMIC_ACQUIRE, "agent");
            xb_add(&bar[XB_XGEN(b.x)], 1u);
            asm volatile("s_waitcnt vmcnt(0)" ::: "memory");
        } else {
            XB_SPIN(xb_ld(&bar[XB_XGEN(b.x)]) == gen, bar);
            __builtin_amdgcn_fence(__ATOMIC_ACQUIRE, "agent");
            asm volatile("s_waitcnt vmcnt(0)" ::: "memory");
        }
    }
    __syncthreads();
}
struct Frame {
    LAS unsigned char* lds;
    volatile LAS unsigned* MISC;
    gu32* ctl;
    int wave;
    int vcu, G;
    float* out;
    unsigned char* ws;
};
__device__ __forceinline__ const float* inp(int k) { auto p = __builtin_amdgcn_kernarg_segment_ptr(); asm volatile("" : "+s"(p)); return ((const float* const*)p)[k]; }
__device__ __forceinline__ int lane_id() { return (int)__builtin_amdgcn_mbcnt_hi(~0u, __builtin_amdgcn_mbcnt_lo(~0u, 0u)); }
__device__ __forceinline__ bf16* segp(const Frame& F, int sg) { return ((bf16*)(F.ws + WS_SEG)) + (size_t)sg * (SEG_BYTES / 2); }
__device__ __forceinline__ float wave_sum(float v) {
#pragma unroll
    for (int o = 1; o < 64; o <<= 1) v += __shfl_xor(v, o);
    return v;
}

__device__ __forceinline__ void p0_transpose_item(const float* W, int K, int N, bf16* WT, const float* kscale, bool permute, LAS float* scr, int item, int lane) {
    const int nblk = N / 32, kb = item / nblk, nb = item % nblk, k0 = 64 * kb, n0 = 32 * nb;
#pragma unroll 8
    for (int i = 0; i < 32; ++i) { const int kk = 2 * i + (lane >> 5); scr[kk * 33 + (lane & 31)] = __builtin_nontemporal_load(W + (size_t)(k0 + kk) * N + n0 + (lane & 31)); }
    LDS_WAIT(); asm volatile("" ::: "memory");
    const int c = lane & 7;
    float ks[8];
#pragma unroll
    for (int e = 0; e < 8; ++e) ks[e] = kscale ? kscale[k0 + 8 * c + e] : 1.0f;
#pragma unroll
    for (int j = 0; j < 4; ++j) { const int n = (lane >> 3) + 8 * j; const LAS float* s = scr + (8 * c) * 33 + n;
        v4u o; o.x = pk2(s[0 * 33] * ks[0], s[1 * 33] * ks[1]); o.y = pk2(s[2 * 33] * ks[2], s[3 * 33] * ks[3]); o.z = pk2(s[4 * 33] * ks[4], s[5 * 33] * ks[5]); o.w = pk2(s[6 * 33] * ks[6], s[7 * 33] * ks[7]);
        int col = n0 + n, row = col;
        if (permute) { const int ol = col & 255; row = (col & ~255) + 128 * ((ol >> 5) & 1) + 32 * (ol >> 6) + (ol & 31); }
        *(GAS v4u*)(WT + (size_t)row * K + k0 + 8 * c) = o; }
    LDS_WAIT(); asm volatile("" ::: "memory");
}
__device__ __forceinline__ void p0_prologue(Frame& F) {
    const int lane = lane_id();
    LAS float* scr = (LAS float*)(F.lds + RING_OFF + F.wave * 16384);
    const int gw = F.vcu * NWAVES + F.wave, NGW = F.G * NWAVES;
    constexpr int I_IN = (D / 64) * (DIN / 32), I_OUT = (D / 64) * (D / 32), I_PLE = (DPLE / 64) * (D / 32), I_G = (D / 64) * (D / 32);
    constexpr int NITEMS = I_IN + I_OUT + I_PLE + I_G;
    for (int it = gw; it < NITEMS; it += NGW) {
        int r = it;
        if (r < I_IN) { p0_transpose_item(inp(7), D, DIN, ((bf16*)(F.ws + WS_WIN)), inp(6), true, scr, r, lane); continue; } r -= I_IN;
        if (r < I_OUT) { p0_transpose_item(inp(15), D, D, ((bf16*)(F.ws + WS_WOUT)), nullptr, true, scr, r, lane); continue; } r -= I_OUT;
        if (r < I_PLE) { p0_transpose_item(inp(16), DPLE, D, ((bf16*)(F.ws + WS_WPLE)), nullptr, true, scr, r, lane); continue; } r -= I_PLE;
        p0_transpose_item(inp(18), D, D, ((bf16*)(F.ws + WS_WG)), nullptr, true, scr, r, lane);
    }
    for (int i = gw * 64 + lane; i < NGRP * 128 * 128; i += NGW * 64) { const int s = i & 127, t = (i >> 7) & 127; const float w = (s <= t) ? inp(8)[i] : 0.f; ((bf16*)(F.ws + WS_WS))[i] = (bf16)(pk2(w, 0.f) & 0xffffu); }
    for (int m = gw; m < M; m += NGW) {
        const float* xrow = (m < MP) ? inp(0) + (size_t)m * D : inp(1) + (size_t)(m - MP) * D;
        const GAS f32x4* xr = (const GAS f32x4*)xrow + lane;
        f32x4 v[4]; float s2 = 0.f;
#pragma unroll
        for (int j = 0; j < 4; ++j) { v[j] = __builtin_nontemporal_load((const f32x4*)(xr + 64 * j)); s2 += (v[j].x * v[j].x + v[j].y * v[j].y) + (v[j].z * v[j].z + v[j].w * v[j].w); }
        s2 = wave_sum(s2);
        if (lane == 0) ((float*)(F.ws + WS_RSTD))[m] = 1.0f / sqrtf(s2 * (1.0f / D) + RMS_EPS);
        GAS v2u* o8 = (GAS v2u*)(((bf16*)(F.ws + WS_XB)) + (size_t)m * D) + lane;
#pragma unroll
        for (int j = 0; j < 4; ++j) { v2u o; o.x = pk2(v[j].x, v[j].y); o.y = pk2(v[j].z, v[j].w); o8[64 * j] = o; }
    }
    for (int i = gw; i < M / 2; i += NGW) {
        const int m = 2 * i; const float* prow = (m < MP) ? inp(4) + (size_t)m * DPLE : inp(5) + (size_t)(m - MP) * DPLE;
        const GAS f32x4* pr = (const GAS f32x4*)prow + 2 * lane; const f32x4 a = __builtin_nontemporal_load((const f32x4*)pr), b = __builtin_nontemporal_load((const f32x4*)(pr + 1));
        v4u o; o.x = pk2(a.x, a.y); o.y = pk2(a.z, a.w); o.z = pk2(b.x, b.y); o.w = pk2(b.z, b.w);
        *((GAS v4u*)(((bf16*)(F.ws + WS_PB)) + (size_t)m * DPLE) + lane) = o;
    }
}

#define DPP_F(v, ctrl) __builtin_bit_cast(float, __builtin_amdgcn_update_dpp(0, __builtin_bit_cast(int, (v)), (ctrl), 0xf, 0xf, true))
__device__ __forceinline__ void glds16_nt(const void* gsrc, unsigned lds_dst) { unsigned keep;
    asm volatile("s_mov_b32 %0, m0\n\ts_mov_b32 m0, %2\n\ts_nop 0\n\tglobal_load_lds_dwordx4 %1, off nt\n\ts_mov_b32 m0, %0" : "=&s"(keep) : "v"(gsrc), "s"(lds_dst) : "memory"); }
__device__ __forceinline__ float head_sum8(float s) { s += DPP_F(s, 0xB1); s += DPP_F(s, 0x4E); s += DPP_F(s, 0x141); return s; }
__device__ __forceinline__ void ld_q8(const bf16* qrow, int lane, float (&q)[8]) {
    const v4u w = *(const GAS v4u*)(qrow + 8 * lane);
    q[0] = bflo(w.x); q[1] = bfhi(w.x); q[2] = bflo(w.y); q[3] = bfhi(w.y); q[4] = bflo(w.z); q[5] = bfhi(w.z); q[6] = bflo(w.w); q[7] = bfhi(w.w);
}
struct SRow4 { f32x4 k0[4], k1[4], v0[4], v1[4]; };
__device__ __forceinline__ void srow4_load_nt(SRow4& R, const float* kp, const float* vp, size_t rstep) {
#pragma unroll
    for (int u = 0; u < 4; ++u) { R.k0[u] = __builtin_nontemporal_load((const f32x4*)(kp + u * rstep)); R.k1[u] = __builtin_nontemporal_load((const f32x4*)(kp + u * rstep + 4));
        R.v0[u] = __builtin_nontemporal_load((const f32x4*)(vp + u * rstep)); R.v1[u] = __builtin_nontemporal_load((const f32x4*)(vp + u * rstep + 4)); }
}
__device__ __forceinline__ void srow4_acc(const SRow4& R, int u, const float (&q)[8], float mult, float (&o)[8], float& l) {
    float s = (q[0] * R.k0[u].x + q[1] * R.k0[u].y) + (q[2] * R.k0[u].z + q[3] * R.k0[u].w) + (q[4] * R.k1[u].x + q[5] * R.k1[u].y) + (q[6] * R.k1[u].z + q[7] * R.k1[u].w);
    s = head_sum8(s); const float p = mult * __builtin_amdgcn_exp2f(s); l += p;
    o[0] += p * R.v0[u].x; o[1] += p * R.v0[u].y; o[2] += p * R.v0[u].z; o[3] += p * R.v0[u].w; o[4] += p * R.v1[u].x; o[5] += p * R.v1[u].y; o[6] += p * R.v1[u].z; o[7] += p * R.v1[u].w;
}
#define S_FENCE() asm volatile("" ::: "memory")
__device__ __forceinline__ void samp_unit(Frame& F, int b) {
    int lane = lane_id(); asm volatile("" : "+v"(lane));
    const int w = F.wave; const size_t m0 = (size_t)MP + b * TS;
    const float* ck = ((const float*)inp(2)) + (size_t)b * WB * DSEG + 8 * lane; const float* cv = ((const float*)inp(3)) + (size_t)b * WB * DSEG + 8 * lane;
    const float* nk = F.out + OUT_KNEW + (size_t)b * TS * DSEG + 8 * lane; const float* nv = F.out + OUT_VNEW + (size_t)b * TS * DSEG + 8 * lane;
    float oa[8], la = 0.f;
#pragma unroll
    for (int e = 0; e < 8; ++e) oa[e] = 0.f;
    float ob0[8], ob1[8], lb0 = 0.f, lb1 = 0.f;
#pragma unroll
    for (int e = 0; e < 8; ++e) { ob0[e] = 0.f; ob1[e] = 0.f; }
    LAS unsigned char* ring = F.lds + RING_OFF + w * 16384; const unsigned ring0 = (unsigned)(uintptr_t)ring;
#define S_DMA_ROW(slot, kp_, vp_) do { const unsigned d_ = (unsigned)__builtin_amdgcn_readfirstlane((int)(ring0 + (slot) * 4096)); \
        glds16_nt((kp_) + 4 * lane_, d_); glds16_nt((kp_) + 256 + 4 * lane_, d_ + 1024); glds16_nt((vp_) + 4 * lane_, d_ + 2048); glds16_nt((vp_) + 256 + 4 * lane_, d_ + 3072); } while (0)
#define S_LDS_ROW(slot, K0, K1, V0, V1) do { const LAS unsigned char* p_ = ring + (slot) * 4096 + 32 * lane_; K0 = *(const LAS f32x4*)p_; K1 = *(const LAS f32x4*)(p_ + 16); V0 = *(const LAS f32x4*)(p_ + 2048); V1 = *(const LAS f32x4*)(p_ + 2064); } while (0)
    const int lane_ = lane;
    const float* ck0 = ((const float*)inp(2)) + (size_t)b * WB * DSEG; const float* cv0 = ((const float*)inp(3)) + (size_t)b * WB * DSEG;
    { float q[8]; ld_q8(segp(F, SG_Q) + (m0 + w) * DSEG, lane, q);
      asm volatile("s_waitcnt vmcnt(0)" ::: "memory");
      const size_t rs = (size_t)16 * DSEG; const float* kb = ck0 + (size_t)w * DSEG; const float* vb = cv0 + (size_t)w * DSEG;
      S_DMA_ROW(0, kb, vb); S_DMA_ROW(1, kb + rs, vb + rs); S_DMA_ROW(2, kb + 2 * rs, vb + 2 * rs);
#pragma unroll 4
      for (int i = 0; i < 96; ++i) {
          { const int in = (i + 3 < 96) ? i + 3 : 95; S_DMA_ROW((i + 3) & 3, kb + (size_t)in * rs, vb + (size_t)in * rs); }
          asm volatile("s_waitcnt vmcnt(12)" ::: "memory");
          { SRow4 R; S_LDS_ROW(i & 3, R.k0[0], R.k1[0], R.v0[0], R.v1[0]); srow4_acc(R, 0, q, 1.0f, oa, la); }
          asm volatile("s_waitcnt lgkmcnt(0)" ::: "memory");
      }
      asm volatile("s_waitcnt vmcnt(0)" ::: "memory"); }
    { float q0[8], q1[8]; const int t0 = w & 3, t1 = t0 + 4; ld_q8(segp(F, SG_Q) + (m0 + t0) * DSEG, lane, q0); ld_q8(segp(F, SG_Q) + (m0 + t1) * DSEG, lane, q1);
      asm volatile("s_waitcnt vmcnt(0)" ::: "memory");
      const size_t rs = (size_t)8 * DSEG; const float* kb = ck0 + (size_t)(1536 + w) * DSEG; const float* vb = cv0 + (size_t)(1536 + w) * DSEG;
      S_DMA_ROW(0, kb, vb); S_DMA_ROW(1, kb + rs, vb + rs); S_DMA_ROW(2, kb + 2 * rs, vb + 2 * rs);
#pragma unroll 4
      for (int i = 0; i < 48; ++i) {
          { const int in = (i + 3 < 48) ? i + 3 : 47; S_DMA_ROW((i + 3) & 3, kb + (size_t)in * rs, vb + (size_t)in * rs); }
          asm volatile("s_waitcnt vmcnt(12)" ::: "memory");
          { SRow4 R; S_LDS_ROW(i & 3, R.k0[0], R.k1[0], R.v0[0], R.v1[0]); const int rho = 1536 + w + 8 * i, d0 = WB + t0 - rho, d1 = WB + t1 - rho;
            srow4_acc(R, 0, q0, (d0 <= 512 ? 1.0f : 0.0f) + ((d0 & 15) == 0 ? 1.0f : 0.0f), ob0, lb0); srow4_acc(R, 0, q1, (d1 <= 512 ? 1.0f : 0.0f) + ((d1 & 15) == 0 ? 1.0f : 0.0f), ob1, lb1); }
          asm volatile("s_waitcnt lgkmcnt(0)" ::: "memory");
      }
      asm volatile("s_waitcnt vmcnt(0)" ::: "memory"); }
#undef S_DMA_ROW
#undef S_LDS_ROW
    __syncthreads();
    float q[8][8], o[8][8], l[8];
#pragma unroll
    for (int t = 0; t < 8; ++t) { ld_q8(segp(F, SG_Q) + (m0 + t) * DSEG, lane, q[t]);
        const bool a0 = (t == (w & 3)), a1 = (t == (w & 3) + 4);
        l[t] = a0 ? lb0 : (a1 ? lb1 : 0.f);
#pragma unroll
        for (int e = 0; e < 8; ++e) o[t][e] = a0 ? ob0[e] : (a1 ? ob1[e] : 0.f); }
    for (int i0 = 0; i0 < 20; i0 += 4) {
        f32x4 k0[4], k1[4], v0[4], v1[4]; int rho[4];
#pragma unroll
        for (int u = 0; u < 4; ++u) { const int i = i0 + u, ic = i < 16 ? i : 16; rho[u] = (i <= 16) ? 1920 + w + 8 * ic : 100000; const int rr = 1920 + w + 8 * ic;
            const float* kr = (rr < WB) ? ck + (size_t)rr * DSEG : nk + (size_t)(rr - WB) * DSEG; const float* vr = (rr < WB) ? cv + (size_t)rr * DSEG : nv + (size_t)(rr - WB) * DSEG;
            k0[u] = *(const f32x4*)kr; k1[u] = *(const f32x4*)(kr + 4); v0[u] = *(const f32x4*)vr; v1[u] = *(const f32x4*)(vr + 4); }
#pragma unroll
        for (int u = 0; u < 4; ++u) {
#pragma unroll
            for (int t = 0; t < 8; ++t) {
                const int dl = WB + t - rho[u];
                const int mult = (dl >= 0 && dl <= 128 ? 1 : 0) + (dl >= 0 && (dl & 3) == 0 && dl <= 512 ? 1 : 0) + (dl >= 0 && (dl & 15) == 0 ? 1 : 0);
                if (mult) {
                    float s = (q[t][0] * k0[u].x + q[t][1] * k0[u].y) + (q[t][2] * k0[u].z + q[t][3] * k0[u].w) + (q[t][4] * k1[u].x + q[t][5] * k1[u].y) + (q[t][6] * k1[u].z + q[t][7] * k1[u].w);
                    s = head_sum8(s); const float p = (float)mult * __builtin_amdgcn_exp2f(s); l[t] += p;
                    o[t][0] += p * v0[u].x; o[t][1] += p * v0[u].y; o[t][2] += p * v0[u].z; o[t][3] += p * v0[u].w; o[t][4] += p * v1[u].x; o[t][5] += p * v1[u].y; o[t][6] += p * v1[u].z; o[t][7] += p * v1[u].w; }
            }
        }
    }
    LAS float* mb = (LAS float*)(F.lds + RING_OFF);
#pragma unroll
    for (int rnd = 0; rnd < 2; ++rnd) {
#pragma unroll
        for (int tq = 0; tq < 4; ++tq) { LAS float* sl = mb + (w * 4 + tq) * 576 + lane * 9;
#pragma unroll
            for (int e = 0; e < 8; ++e) sl[e] = o[4 * rnd + tq][e];
            sl[8] = l[4 * rnd + tq]; }
        __syncthreads();
        if ((w >> 2) == rnd) { const int tq = w & 3;
#pragma unroll
            for (int ww = 0; ww < 8; ++ww) { const LAS float* sl = mb + (ww * 4 + tq) * 576 + lane * 9;
#pragma unroll
                for (int e = 0; e < 8; ++e) oa[e] += sl[e];
                la += sl[8]; } }
        __syncthreads();
    }
    const float inv = 1.0f / la; float ss = 0.f;
#pragma unroll
    for (int e = 0; e < 8; ++e) { oa[e] *= inv; ss += oa[e] * oa[e]; }
    ss = head_sum8(ss);
    const float rn = 1.0f / sqrtf(ss * (1.0f / HD) + RMS_EPS);
    const f32x4 g0 = *(const f32x4*)(inp(14) + 8 * lane), g1 = *(const f32x4*)(inp(14) + 8 * lane + 4);
    const size_t m = m0 + w;
    const v4u z = *(const GAS v4u*)(segp(F, SG_ZB) + m * DSEG + 8 * lane);
    v4u wv; wv.x = pk2(oa[0] * rn * g0.x * bflo(z.x), oa[1] * rn * g0.y * bfhi(z.x)); wv.y = pk2(oa[2] * rn * g0.z * bflo(z.y), oa[3] * rn * g0.w * bfhi(z.y));
    wv.z = pk2(oa[4] * rn * g1.x * bflo(z.z), oa[5] * rn * g1.y * bfhi(z.z)); wv.w = pk2(oa[6] * rn * g1.z * bflo(z.w), oa[7] * rn * g1.w * bfhi(z.w));
    *(GAS v4u*)(((bf16*)(F.ws + WS_MIX)) + m * D + DSEG + 8 * lane) = wv;
}

constexpr int VN_PITCH = 272, GM_VN = 0, GM_U = 128 * VN_PITCH, GM_Z = 2 * 128 * VN_PITCH, GM_P = 3 * 128 * VN_PITCH;
__device__ __forceinline__ s16x4 tr16(const LAS unsigned char* p) { return __builtin_bit_cast(s16x4, __builtin_amdgcn_ds_read_tr16_b64_v4i16((LAS s16x4*)p)); }
struct GmRegs { v4u rv[4], ru[4], rz[4]; bf16x8 wf[4]; };
__device__ __forceinline__ void gmlp_load(Frame& F, GmRegs& R, int m0, int g, int lane, int w) {
    const int tid = w * 64 + lane, t = 16 * w + (lane & 15), gq4 = lane >> 4;
    const size_t roff = (size_t)(m0 + (tid >> 4)) * DSEG + g * GA + 8 * (tid & 15);
    const bf16* pv = segp(F, SG_VA) + roff; const bf16* pu = segp(F, SG_U) + roff; const bf16* pz = segp(F, SG_ZA) + roff;
#pragma unroll
    for (int i = 0; i < 4; ++i) R.rv[i] = __builtin_nontemporal_load((const v4u*)(pv + (size_t)(32 * i) * DSEG));
    const bf16* wsrow = ((bf16*)(F.ws + WS_WS)) + ((size_t)g * 128 + t) * 128 + 8 * gq4;
#pragma unroll
    for (int ks = 0; ks < 4; ++ks) R.wf[ks] = *(const GAS bf16x8*)(wsrow + 32 * ks);
#pragma unroll
    for (int i = 0; i < 4; ++i) { R.ru[i] = __builtin_nontemporal_load((const v4u*)(pu + (size_t)(32 * i) * DSEG)); R.rz[i] = __builtin_nontemporal_load((const v4u*)(pz + (size_t)(32 * i) * DSEG)); }
}
__device__ __forceinline__ void gmlp_compute(Frame& F, const GmRegs& R, int m0, int g, int lane, int w) {
    LAS unsigned char* img = F.lds + RING_OFF;
    const int tid = w * 64 + lane, srow = tid >> 4, sch = tid & 15;
    const int t = 16 * w + (lane & 15), gq4 = lane >> 4;
    { const LAS float* gv = (const LAS float*)(img + GM_P) + g * GA + 8 * sch;
      const f32x4 ga = *(const LAS f32x4*)gv, gb = *(const LAS f32x4*)(gv + 4);
#pragma unroll
      for (int i = 0; i < 4; ++i) { const v4u r = R.rv[i]; float f[8];
          f[0] = bflo(r.x); f[1] = bfhi(r.x); f[2] = bflo(r.y); f[3] = bfhi(r.y); f[4] = bflo(r.z); f[5] = bfhi(r.z); f[6] = bflo(r.w); f[7] = bfhi(r.w);
          float ss = (f[0] * f[0] + f[1] * f[1]) + (f[2] * f[2] + f[3] * f[3]) + (f[4] * f[4] + f[5] * f[5]) + (f[6] * f[6] + f[7] * f[7]);
          ss += DPP_F(ss, 0xB1); ss += DPP_F(ss, 0x4E); ss += DPP_F(ss, 0x141); ss += DPP_F(ss, 0x140);
          const float rn = 1.0f / sqrtf(ss * (1.0f / GA) + RMS_EPS);
          v4u o; o.x = pk2(f[0] * rn * ga.x, f[1] * rn * ga.y); o.y = pk2(f[2] * rn * ga.z, f[3] * rn * ga.w); o.z = pk2(f[4] * rn * gb.x, f[5] * rn * gb.y); o.w = pk2(f[6] * rn * gb.z, f[7] * rn * gb.w);
          const int off = (32 * i + srow) * VN_PITCH + 16 * sch;
          *(LAS v4u*)(img + GM_VN + off) = o; *(LAS v4u*)(img + GM_U + off) = R.ru[i]; *(LAS v4u*)(img + GM_Z + off) = R.rz[i]; } }
    __syncthreads();
    f32x4 acc[8];
#pragma unroll
    for (int ct = 0; ct < 8; ++ct) acc[ct] = (f32x4){0.f, 0.f, 0.f, 0.f};
    const int q4 = (lane & 15) >> 2, p4 = lane & 3;
    const LAS unsigned char* trb = img + GM_VN + (8 * gq4 + q4) * VN_PITCH + 8 * p4;
    const int nks = (16 * w + 15) / 32 + 1;
#pragma unroll
    for (int ks = 0; ks < 4; ++ks) {
        if (ks < nks) {
#pragma unroll
            for (int ct = 0; ct < 8; ++ct) {
                const s16x4 lo = tr16(trb + (32 * ks) * VN_PITCH + 32 * ct), hi = tr16(trb + (32 * ks + 4) * VN_PITCH + 32 * ct);
                const bf16x8 vf = (bf16x8){lo[0], lo[1], lo[2], lo[3], hi[0], hi[1], hi[2], hi[3]};
                acc[ct] = __builtin_amdgcn_mfma_f32_16x16x32_bf16(vf, R.wf[ks], acc[ct], 0, 0, 0);
            } } }
    const float bs = ((const LAS float*)(img + GM_P))[1024 + g * 128 + t];
    LAS unsigned char* urow = img + GM_U + t * VN_PITCH + 8 * gq4; const LAS unsigned char* zrow = img + GM_Z + t * VN_PITCH + 8 * gq4;
    float a[8][4]; float ss = 0.f;
#pragma unroll
    for (int ct = 0; ct < 8; ++ct) { const v2u uu = *(const LAS v2u*)(urow + 32 * ct);
        a[ct][0] = bflo(uu.x) * (acc[ct][0] + bs); a[ct][1] = bfhi(uu.x) * (acc[ct][1] + bs); a[ct][2] = bflo(uu.y) * (acc[ct][2] + bs); a[ct][3] = bfhi(uu.y) * (acc[ct][3] + bs);
        ss += (a[ct][0] * a[ct][0] + a[ct][1] * a[ct][1]) + (a[ct][2] * a[ct][2] + a[ct][3] * a[ct][3]); }
    ss += __shfl_xor(ss, 16); ss += __shfl_xor(ss, 32);
    const float rn = 1.0f / sqrtf(ss * (1.0f / GA) + RMS_EPS);
#pragma unroll
    for (int ct = 0; ct < 8; ++ct) { const v2u zz = *(const LAS v2u*)(zrow + 32 * ct); const f32x4 go = *(const LAS f32x4*)((const LAS float*)(img + GM_P) + 512 + g * GA + 16 * ct + 4 * gq4);
        v2u o; o.x = pk2(a[ct][0] * rn * go.x * bflo(zz.x), a[ct][1] * rn * go.y * bfhi(zz.x)); o.y = pk2(a[ct][2] * rn * go.z * bflo(zz.y), a[ct][3] * rn * go.w * bfhi(zz.y));
        *(LAS v2u*)(urow + 32 * ct) = o; }
    __syncthreads();
    { bf16* po = ((bf16*)(F.ws + WS_MIX)) + (size_t)(m0 + srow) * D + g * GA + 8 * sch;
#pragma unroll
      for (int i = 0; i < 4; ++i) *(GAS v4u*)(po + (size_t)(32 * i) * D) = *(const LAS v4u*)(img + GM_U + (32 * i + srow) * VN_PITCH + 16 * sch); }
    __syncthreads();
}
__device__ __forceinline__ void gmlp_batch(Frame& F, int m0) {
    int lane = lane_id(); asm volatile("" : "+v"(lane)); const int w = F.wave;
    GmRegs R0, R1;
    { LAS float* pt = (LAS float*)(F.lds + RING_OFF + GM_P); const int tid = w * 64 + lane;
      pt[tid] = inp(10)[tid]; pt[512 + tid] = inp(11)[tid]; pt[1024 + tid] = inp(9)[tid]; }
    gmlp_load(F, R0, m0, 0, lane, w);
    __syncthreads();
    gmlp_load(F, R1, m0, 1, lane, w); gmlp_compute(F, R0, m0, 0, lane, w);
    gmlp_load(F, R0, m0, 2, lane, w); gmlp_compute(F, R1, m0, 1, lane, w);
    gmlp_load(F, R1, m0, 3, lane, w); gmlp_compute(F, R0, m0, 2, lane, w);
    gmlp_compute(F, R1, m0, 3, lane, w);
}
__device__ __forceinline__ void gmlp_sample_task(Frame& F, int b, int g) {
    int lane = lane_id(); asm volatile("" : "+v"(lane)); const int c = g * GA + 2 * lane; const size_t m0 = (size_t)MP + b * TS;
    float vn0[8], vn1[8];
    const float gv0 = inp(10)[c], gv1 = inp(10)[c + 1], go0 = inp(11)[c], go1 = inp(11)[c + 1];
#pragma unroll
    for (int t = 0; t < 8; ++t) {
        const unsigned r = *(const GAS unsigned*)(segp(F, SG_VA) + (m0 + t) * DSEG + c); const float a0 = bflo(r), a1 = bfhi(r);
        const float ss = wave_sum(a0 * a0 + a1 * a1); const float rn = 1.0f / sqrtf(ss * (1.0f / GA) + RMS_EPS);
        vn0[t] = a0 * rn * gv0; vn1[t] = a1 * rn * gv1;
        float* vo = F.out + OUT_VACH + ((size_t)b * TS + t) * DSEG + c; vo[0] = vn0[t]; vo[1] = vn1[t];
    }
#pragma unroll
    for (int t = 0; t < 8; ++t) {
        float m0v = inp(9)[g * 128 + t], m1v = m0v;
#pragma unroll
        for (int s = 0; s <= t; ++s) { const float w = inp(8)[((size_t)g * 128 + t) * 128 + s]; m0v += w * vn0[s]; m1v += w * vn1[s]; }
        const unsigned ur = *(const GAS unsigned*)(segp(F, SG_U) + (m0 + t) * DSEG + c), zr = *(const GAS unsigned*)(segp(F, SG_ZA) + (m0 + t) * DSEG + c);
        const float a0 = bflo(ur) * m0v, a1 = bfhi(ur) * m1v;
        const float ss = wave_sum(a0 * a0 + a1 * a1); const float rn = 1.0f / sqrtf(ss * (1.0f / GA) + RMS_EPS);
        *(GAS unsigned*)(((bf16*)(F.ws + WS_MIX)) + (m0 + t) * D + c) = pk2(a0 * rn * go0 * bflo(zr), a1 * rn * go1 * bfhi(zr));
    }
}

constexpr int TJ_SLOT = 32768, TJ_NSLOT = 4, TJ_X = TJ_NSLOT * TJ_SLOT, TJ_XB = 4608;
static_assert(TJ_X + 4 * TJ_XB <= LDSCTL_OFF, "attention LDS");
__device__ __forceinline__ int crow(int reg, int h2) { return (reg & 3) + 8 * (reg >> 2) + 4 * h2; }
__device__ __forceinline__ void glds16(const void* gsrc, unsigned lds_dst) { unsigned keep;
    asm volatile("s_mov_b32 %0, m0\n\ts_mov_b32 m0, %2\n\ts_nop 0\n\tglobal_load_lds_dwordx4 %1, off\n\ts_mov_b32 m0, %0" : "=&s"(keep) : "v"(gsrc), "s"(lds_dst) : "memory"); }
__device__ __forceinline__ void tj_dma_block(const bf16* Kg, const bf16* Vg, int r, int c, int kb, unsigned lds0, int slot, int w, int lane) {
#pragma unroll
    for (int pi = 0; pi < 2; ++pi) { const int i = w + 8 * pi, row = 8 * i + (lane >> 3), cp = lane & 7;
        const size_t rowoff = (size_t)(c + r * (kb + row)) * DSEG;
        glds16(Kg + rowoff + 8 * (cp ^ ((row >> 1) & 7)), (unsigned)__builtin_amdgcn_readfirstlane((int)(lds0 + slot * TJ_SLOT + i * 1024)));
        glds16(Vg + rowoff + 8 * (cp ^ (4 * ((row >> 1) & 1))), (unsigned)__builtin_amdgcn_readfirstlane((int)(lds0 + slot * TJ_SLOT + 16384 + i * 1024))); }
}
__device__ __forceinline__ void tj_unit(Frame& F, int b, int h, int type, int x) {
    int lane = lane_id(); asm volatile("" : "+v"(lane));
    const int w = F.wave, r32 = lane & 31, h2 = lane >> 5, a = w & 3, hh = w >> 2;
    const int r = (type == 0) ? 1 : (type == 1 ? 4 : 16);
    const size_t hb = (size_t)b * SEQ * DSEG + h * HD;
    const bf16 *Qg = segp(F, SG_Q) + hb, *Kg = segp(F, SG_K) + hb, *Vg = segp(F, SG_V) + hb;
    bf16* PO = (bf16*)(F.ws + WS_PO) + (size_t)type * ((size_t)MP * DSEG) + hb; float* PL = (float*)(F.ws + WS_PL) + (size_t)type * ((size_t)MP * NH) + (size_t)b * SEQ * NH + h;
    LAS unsigned char* L = F.lds + RING_OFF; const unsigned lds0 = (unsigned)(uintptr_t)L;
    const int lead = (type == 0 && x == 1) ? 1 : 0, nent = 8 + lead;
#define TJ_JC(jj) ((type == 0) ? 0 : ((type == 1) ? 2 * x + ((jj) >> 2) : 8 * x + (jj)))
#define TJ_JN(jj) ((type == 0) ? 8 * x + (jj) : ((type == 1) ? ((jj) & 3) : 0))
#define TJ_EC(e) ((type == 0) ? 0 : ((type == 1) ? 2 * x + ((e) >> 2) : 8 * x + (e)))
#define TJ_EN(e) ((type == 0) ? 8 * x + (e) - lead : ((type == 1) ? ((e) & 3) : 0))
#define TJ_QROW(jj) (Qg + (size_t)(TJ_JC(jj) + r * (128 * TJ_JN(jj) + 32 * a + r32)) * DSEG + 8 * h2)
    for (int e = 0; e <= lead + 1; ++e) tj_dma_block(Kg, Vg, r, TJ_EC(e), 128 * TJ_EN(e), lds0, e & 3, w, lane);
    bf16x8 qf[4], qa[4];
    { const bf16* q0 = TJ_QROW(0); const bf16* q1 = TJ_QROW(1);
#pragma unroll
      for (int st = 0; st < 4; ++st) { qf[st] = *(const GAS bf16x8*)(q0 + 16 * st); qa[st] = *(const GAS bf16x8*)(q1 + 16 * st); } }
    asm volatile("s_waitcnt vmcnt(0) lgkmcnt(0)" ::: "memory"); __builtin_amdgcn_s_barrier(); asm volatile("" ::: "memory");
    asm volatile("" : "+v"(qf[0]), "+v"(qf[1]), "+v"(qf[2]), "+v"(qf[3]), "+v"(qa[0]), "+v"(qa[1]), "+v"(qa[2]), "+v"(qa[3]));
    const int q4 = (lane & 15) >> 2, p4 = lane & 3, blk = (lane >> 4) & 1;
    const int kswz = (r32 >> 1) & 7, vswz = 4 * ((q4 >> 1) & 1);
#pragma unroll 1
    for (int jj = 0; jj < 8; ++jj) {
        const int cj = TJ_JC(jj), nj = TJ_JN(jj), ci = jj + lead; const bool has_prev = nj > 0, fin = (hh == (jj & 1));
        const int prev_slot = (ci + 3) & 3, cur_slot = ci & 3;
        bf16x8 qb[4];
        { const int j2 = (jj + 2 < 8) ? jj + 2 : 7; const bf16* q2 = TJ_QROW(j2);
#pragma unroll
          for (int st = 0; st < 4; ++st) asm volatile("global_load_dwordx4 %0, %1, off" : "=v"(qb[st]) : "v"(q2 + 16 * st) : "memory"); }
        const bool dma = (ci + 2 < nent);
        if (dma) tj_dma_block(Kg, Vg, r, TJ_EC(ci + 2), 128 * TJ_EN(ci + 2), lds0, (ci + 2) & 3, w, lane);
        f32x16 o0, o1; float lsum = 0.f;
#pragma unroll
        for (int i = 0; i < 16; ++i) { o0[i] = 0.f; o1[i] = 0.f; }
        const int jlo = fin ? a + 3 : a, jhi = fin ? a + 4 : a + 2;
#pragma unroll 1
        for (int j = jlo; j <= jhi; ++j) {
            if (j < 4 && !has_prev) continue;
            const LAS unsigned char* sl = L + ((j < 4) ? prev_slot : cur_slot) * TJ_SLOT + 32 * (j & 3) * 128;
            bf16x8 kf[4];
#pragma unroll
            for (int st = 0; st < 4; ++st) kf[st] = *(const LAS bf16x8*)(sl + r32 * 128 + 16 * ((2 * st + h2) ^ kswz));
            f32x16 xx;
#pragma unroll
            for (int i = 0; i < 16; ++i) xx[i] = 0.f;
#pragma unroll
            for (int st = 0; st < 4; ++st) xx = __builtin_amdgcn_mfma_f32_32x32x16_bf16(kf[st], qf[st], xx, 0, 0, 0);
            const bool mfirst = (j == a), mlast = (j == a + 4); float ps = 0.f;
            if (mfirst || mlast) {
#pragma unroll
                for (int i = 0; i < 16; ++i) { const int kr = crow(i, h2); const bool valid = (!mfirst || kr >= r32) && (!mlast || kr <= r32);
                    const float p = valid ? __builtin_amdgcn_exp2f(xx[i]) : 0.f; xx[i] = p; ps += p; }
            } else {
#pragma unroll
                for (int i = 0; i < 16; ++i) { const float p = __builtin_amdgcn_exp2f(xx[i]); xx[i] = p; ps += p; }
            }
            lsum += ps;
            v4u pw0, pw1; pw0.x = pk2(xx[0], xx[1]); pw0.y = pk2(xx[2], xx[3]); pw0.z = pk2(xx[4], xx[5]); pw0.w = pk2(xx[6], xx[7]);
            pw1.x = pk2(xx[8], xx[9]); pw1.y = pk2(xx[10], xx[11]); pw1.z = pk2(xx[12], xx[13]); pw1.w = pk2(xx[14], xx[15]);
            const bf16x8 pf0 = __builtin_bit_cast(bf16x8, pw0), pf1 = __builtin_bit_cast(bf16x8, pw1);
            const LAS unsigned char* vb = sl + 16384 + (4 * h2 + q4) * 128 + 8 * (p4 & 1);
            const int ch0 = (2 * blk + (p4 >> 1)) ^ vswz, ch1 = (4 + 2 * blk + (p4 >> 1)) ^ vswz;
            const s16x4 a0 = tr16(vb + 0 * 128 + 16 * ch0), a1 = tr16(vb + 8 * 128 + 16 * ch0), b0 = tr16(vb + 16 * 128 + 16 * ch0), b1 = tr16(vb + 24 * 128 + 16 * ch0);
            const s16x4 c0v = tr16(vb + 0 * 128 + 16 * ch1), c1v = tr16(vb + 8 * 128 + 16 * ch1), d0v = tr16(vb + 16 * 128 + 16 * ch1), d1v = tr16(vb + 24 * 128 + 16 * ch1);
            const bf16x8 v00 = (bf16x8){a0[0], a0[1], a0[2], a0[3], a1[0], a1[1], a1[2], a1[3]}, v01 = (bf16x8){b0[0], b0[1], b0[2], b0[3], b1[0], b1[1], b1[2], b1[3]};
            const bf16x8 v10 = (bf16x8){c0v[0], c0v[1], c0v[2], c0v[3], c1v[0], c1v[1], c1v[2], c1v[3]}, v11 = (bf16x8){d0v[0], d0v[1], d0v[2], d0v[3], d1v[0], d1v[1], d1v[2], d1v[3]};
            o0 = __builtin_amdgcn_mfma_f32_32x32x16_bf16(v00, pf0, o0, 0, 0, 0); o0 = __builtin_amdgcn_mfma_f32_32x32x16_bf16(v01, pf1, o0, 0, 0, 0);
            o1 = __builtin_amdgcn_mfma_f32_32x32x16_bf16(v10, pf0, o1, 0, 0, 0); o1 = __builtin_amdgcn_mfma_f32_32x32x16_bf16(v11, pf1, o1, 0, 0, 0);
        }
        lsum += __shfl_xor(lsum, 32);
        LAS unsigned* xs = (LAS unsigned*)(L + TJ_X + a * TJ_XB) + lane * 17;
        if (!fin) {
#pragma unroll
            for (int i = 0; i < 8; ++i) { xs[i] = pk2(o0[2 * i], o0[2 * i + 1]); xs[8 + i] = pk2(o1[2 * i], o1[2 * i + 1]); }
            xs[16] = __float_as_uint(lsum); }
        if (dma) asm volatile("s_waitcnt vmcnt(4) lgkmcnt(0)" ::: "memory"); else asm volatile("s_waitcnt vmcnt(0) lgkmcnt(0)" ::: "memory");
        __builtin_amdgcn_s_barrier(); asm volatile("" ::: "memory");
        asm volatile("" : "+v"(qb[0]), "+v"(qb[1]), "+v"(qb[2]), "+v"(qb[3]));
#pragma unroll
        for (int st = 0; st < 4; ++st) { qf[st] = qa[st]; qa[st] = qb[st]; }
        if (fin) {
#pragma unroll
            for (int i = 0; i < 8; ++i) { const unsigned ua = xs[i], ub = xs[8 + i]; o0[2 * i] += bflo(ua); o0[2 * i + 1] += bfhi(ua); o1[2 * i] += bflo(ub); o1[2 * i + 1] += bfhi(ub); }
            lsum += __uint_as_float(xs[16]);
            LAS unsigned char* stg = L + TJ_X + a * TJ_XB;
            asm volatile("s_waitcnt lgkmcnt(0)" ::: "memory");
#pragma unroll
            for (int g = 0; g < 4; ++g) { v2u ua; ua.x = pk2(o0[4 * g], o0[4 * g + 1]); ua.y = pk2(o0[4 * g + 2], o0[4 * g + 3]); *(LAS v2u*)(stg + r32 * 144 + 8 * h2 + 16 * g) = ua;
                v2u uc; uc.x = pk2(o1[4 * g], o1[4 * g + 1]); uc.y = pk2(o1[4 * g + 2], o1[4 * g + 3]); *(LAS v2u*)(stg + r32 * 144 + 64 + 8 * h2 + 16 * g) = uc; }
            asm volatile("s_waitcnt lgkmcnt(0)" ::: "memory");
            const size_t pos0 = (size_t)(cj + r * (128 * nj + 32 * a));
#pragma unroll
            for (int i = 0; i < 4; ++i) { const int row = 8 * i + (lane >> 3), ch = lane & 7; const v4u v = *(const LAS v4u*)(stg + row * 144 + 16 * ch);
                *(GAS v4u*)(PO + (pos0 + (size_t)r * row) * DSEG + 8 * ch) = v; }
            if (h2 == 0) PL[(pos0 + (size_t)r * r32) * NH] = lsum;
        }
    }
#undef TJ_JC
#undef TJ_JN
#undef TJ_EC
#undef TJ_EN
#undef TJ_QROW
    asm volatile("s_waitcnt vmcnt(0) lgkmcnt(0)" ::: "memory"); __builtin_amdgcn_s_barrier(); asm volatile("" ::: "memory");
}
__device__ __forceinline__ void attn_finish_row(Frame& F, size_t m, int lane) {
    const bf16* po = (const bf16*)(F.ws + WS_PO) + m * DSEG + 8 * lane; const float* pl = (const float*)(F.ws + WS_PL) + m * NH + (lane >> 3);
    const v4u p0 = *(const GAS v4u*)po, p1 = *(const GAS v4u*)(po + (size_t)MP * DSEG), p2 = *(const GAS v4u*)(po + 2 * (size_t)MP * DSEG);
    const float l = pl[0] + pl[(size_t)MP * NH] + pl[2 * (size_t)MP * NH];
    const v4u z = __builtin_nontemporal_load((const v4u*)(segp(F, SG_ZB) + m * DSEG + 8 * lane));
    const f32x4 g0 = *(const f32x4*)(inp(14) + 8 * lane), g1 = *(const f32x4*)(inp(14) + 8 * lane + 4);
    const float inv = 1.0f / l; float o[8];
    o[0] = (bflo(p0.x) + bflo(p1.x) + bflo(p2.x)) * inv; o[1] = (bfhi(p0.x) + bfhi(p1.x) + bfhi(p2.x)) * inv; o[2] = (bflo(p0.y) + bflo(p1.y) + bflo(p2.y)) * inv; o[3] = (bfhi(p0.y) + bfhi(p1.y) + bfhi(p2.y)) * inv;
    o[4] = (bflo(p0.z) + bflo(p1.z) + bflo(p2.z)) * inv; o[5] = (bfhi(p0.z) + bfhi(p1.z) + bfhi(p2.z)) * inv; o[6] = (bflo(p0.w) + bflo(p1.w) + bflo(p2.w)) * inv; o[7] = (bfhi(p0.w) + bfhi(p1.w) + bfhi(p2.w)) * inv;
    float ss = 0.f;
#pragma unroll
    for (int e = 0; e < 8; ++e) ss += o[e] * o[e];
    ss = head_sum8(ss);
    const float rn = 1.0f / sqrtf(ss * (1.0f / HD) + RMS_EPS);
    v4u wv; wv.x = pk2(o[0] * rn * g0.x * bflo(z.x), o[1] * rn * g0.y * bfhi(z.x)); wv.y = pk2(o[2] * rn * g0.z * bflo(z.y), o[3] * rn * g0.w * bfhi(z.y));
    wv.z = pk2(o[4] * rn * g1.x * bflo(z.z), o[5] * rn * g1.y * bfhi(z.z)); wv.w = pk2(o[6] * rn * g1.z * bflo(z.w), o[7] * rn * g1.w * bfhi(z.w));
    *(GAS v4u*)(((bf16*)(F.ws + WS_MIX)) + m * D + DSEG + 8 * lane) = wv;
}

constexpr int ST_PITCH = 68;
template <int MODE  > __device__ __forceinline__ void small_tile(Frame& F, int tile, const bf16* A, const bf16* Bt) {
    const int lane = lane_id(), w = F.wave, tm = tile >> 4, tn = tile & 15;
    const int l15 = lane & 15, lq = lane >> 4;
    const bf16* ap = A + (size_t)(MP + tm * 64 + l15) * D + 128 * w + 8 * lq;
    const bf16* bp = Bt + (size_t)(tn * 64 + l15) * D + 128 * w + 8 * lq;
    f32x4 acc[4][4];
#pragma unroll
    for (int mi = 0; mi < 4; ++mi)
#pragma unroll
        for (int ni = 0; ni < 4; ++ni) acc[mi][ni] = (f32x4){0.f, 0.f, 0.f, 0.f};
    bf16x8 af[4][4], bfr[4][4];
#pragma unroll
    for (int ks = 0; ks < 4; ++ks)
#pragma unroll
        for (int i = 0; i < 4; ++i) { af[ks][i] = *(const GAS bf16x8*)(ap + (size_t)(16 * i) * D + 32 * ks); bfr[ks][i] = *(const GAS bf16x8*)(bp + (size_t)(16 * i) * D + 32 * ks); }
#pragma unroll
    for (int ks = 0; ks < 4; ++ks)
#pragma unroll
        for (int mi = 0; mi < 4; ++mi)
#pragma unroll
            for (int ni = 0; ni < 4; ++ni) acc[mi][ni] = __builtin_amdgcn_mfma_f32_16x16x32_bf16(bfr[ks][ni], af[ks][mi], acc[mi][ni], 0, 0, 0);
    LAS float* part = (LAS float*)(F.lds + RING_OFF) + w * (64 * ST_PITCH);
#pragma unroll
    for (int mi = 0; mi < 4; ++mi)
#pragma unroll
        for (int ni = 0; ni < 4; ++ni) *(LAS f32x4*)(part + (16 * mi + l15) * ST_PITCH + 16 * ni + 4 * lq) = acc[mi][ni];
    __syncthreads();
    const int r = 8 * w + (lane >> 3), c0 = 8 * (lane & 7);
    f32x4 s0 = (f32x4){0.f, 0.f, 0.f, 0.f}, s1 = s0;
#pragma unroll
    for (int ww = 0; ww < 8; ++ww) { const LAS float* p = (const LAS float*)(F.lds + RING_OFF) + ww * (64 * ST_PITCH) + r * ST_PITCH + c0; s0 += *(const LAS f32x4*)p; s1 += *(const LAS f32x4*)(p + 4); }
    const int slot0 = tn * 64 + c0, oc0 = (slot0 & ~255) + 64 * ((slot0 >> 5) & 3) + 32 * ((slot0 >> 7) & 1) + (slot0 & 31);
    const size_t row = (size_t)MP + tm * 64 + r; const size_t off = row * D + oc0;
    if (MODE == 0) {
        const v4u x = *(const GAS v4u*)(((const bf16*)(F.ws + WS_XB)) + off);
        v4u o; o.x = pk2(bflo(x.x) + s0.x, bfhi(x.x) + s0.y); o.y = pk2(bflo(x.y) + s0.z, bfhi(x.y) + s0.w); o.z = pk2(bflo(x.z) + s1.x, bfhi(x.z) + s1.y); o.w = pk2(bflo(x.w) + s1.z, bfhi(x.w) + s1.w);
        *(GAS v4u*)(((bf16*)(F.ws + WS_HB)) + off) = o;
    } else {
        const v4u h = *(const GAS v4u*)(((const bf16*)(F.ws + WS_HB)) + off), e = *(const GAS v4u*)(((const bf16*)(F.ws + WS_ERAW)) + off);
        const float re = ((const float*)(F.ws + WS_RSTDE))[row]; const float* gp = inp(17) + oc0; const f32x4 g0 = *(const f32x4*)gp, g1 = *(const f32x4*)(gp + 4);
        f32x4 y0, y1;
        y0.x = bflo(h.x) + fast_sigmoid(s0.x) * (bflo(e.x) * re * g0.x); y0.y = bfhi(h.x) + fast_sigmoid(s0.y) * (bfhi(e.x) * re * g0.y); y0.z = bflo(h.y) + fast_sigmoid(s0.z) * (bflo(e.y) * re * g0.z); y0.w = bfhi(h.y) + fast_sigmoid(s0.w) * (bfhi(e.y) * re * g0.w);
        y1.x = bflo(h.z) + fast_sigmoid(s1.x) * (bflo(e.z) * re * g1.x); y1.y = bfhi(h.z) + fast_sigmoid(s1.y) * (bfhi(e.z) * re * g1.y); y1.z = bflo(h.w) + fast_sigmoid(s1.z) * (bflo(e.w) * re * g1.z); y1.w = bfhi(h.w) + fast_sigmoid(s1.w) * (bfhi(e.w) * re * g1.w);
        float* yo = F.out + OUT_Y + off; *(f32x4*)yo = y0; *(f32x4*)(yo + 4) = y1;
    }
    __syncthreads();
}

struct Args { const float* in[19]; float* out; unsigned char* ws; int ph_lo, ph_hi, qlo, qhi; };
__global__ void __launch_bounds__(NWAVES * 64, 2) hymba_fwd(Args args) {
    extern __shared__ __attribute__((aligned(16))) unsigned char lds[];
    Frame F;
    F.lds = (LAS unsigned char*)lds;
    F.MISC = (volatile LAS unsigned*)(F.lds + MISC_OFF);
    F.wave = __builtin_amdgcn_readfirstlane((int)threadIdx.x >> 6);
    F.G = gridDim.x; { const int bx = blockIdx.x; F.vcu = (F.G % 8 == 0) ? (bx % 8) * (F.G / 8) + bx / 8 : bx; }
    unsigned char* ws = args.ws;
    F.ctl = (gu32*)(ws + WS_CTL); F.ws = ws;
    F.out = args.out;
    for (int u = (int)threadIdx.x; u < (LDS_BYTES - LDSCTL_OFF) / 4; u += NWAVES * 64) ((LAS unsigned*)(F.lds + LDSCTL_OFF))[u] = 0u;
    __syncthreads();
    XcdBarrier bar; bar.wave = F.wave; bar.bar = (unsigned*)(F.ctl + CW_BAR); bar.x = 0; bar.st = nullptr;
    if (N_LAUNCHES != PER_PHASE) bar = xcd_barrier_post((unsigned*)(F.ctl + CW_BAR), F.MISC + 8);
#define GRID_BAR(seam) do { if (N_LAUNCHES == PER_PHASE) { if (F.wave == 0 && lane_id() == 0) __hip_atomic_store(F.ctl + CW_TMO, 0xBADBA0u | (unsigned)(seam), RLX_AGENT); } else { xcd_barrier(bar); } } while (0)
    const int lo = args.ph_lo, hi = args.ph_hi;
#define IN(k) (lo <= (k) && (k) < hi)
#define BOTH(k) (IN(k) && IN((k) + 1))
    const int gw = F.vcu * NWAVES + F.wave, NGW = F.G * NWAVES;

    if (IN(0)) { p0_prologue(F); if (BOTH(0)) GRID_BAR(0); }

    if (IN(1)) {
        { pg8::Gemm g{((bf16*)(F.ws + WS_XB)), ((bf16*)(F.ws + WS_WIN)), M, DIN, D}; pg8::StaticOrder S; S.init(M, DIN, F.G, (int)blockIdx.x);
          pg8::EpiInProj E{((float*)(F.ws + WS_RSTD)), ((bf16*)(F.ws + WS_SEG)), SEG_BYTES / 2, F.out + OUT_KWIN, F.out + OUT_VWIN, F.out + OUT_KNEW, F.out + OUT_VNEW, inp(12), inp(13), MP, F.lds + pg8::STG_OFF};
          pg8::gemm_phase<pg8::EpiInProj, pg8::StaticOrder, true, true>(F.lds + RING_OFF, g, S, E, F.wave); }
        { int kple = DPLE; asm volatile("" : "+s"(kple));
          pg8::Gemm g{((bf16*)(F.ws + WS_PB)), ((bf16*)(F.ws + WS_WPLE)), M, D, kple}; pg8::FillOrder S; S.init(M, D, F.G, (int)blockIdx.x, (M / 256) * (DIN / 256));
          pg8::EpiPle E{((bf16*)(F.ws + WS_ERAW)), ((float*)(F.ws + WS_ESS)), F.lds + pg8::STG_OFF};
          pg8::gemm_phase<pg8::EpiPle, pg8::FillOrder, true, true>(F.lds + RING_OFF, g, S, E, F.wave); }
        if (BOTH(1)) GRID_BAR(1);
    }

    if (IN(2)) {
        for (int m = gw * 64 + lane_id(); m < M; m += NGW * 64) { const f32x4* e = (const f32x4*)(((float*)(F.ws + WS_ESS)) + (size_t)m * 16); const f32x4 a = e[0], b = e[1], c = e[2], d = e[3];
            const float ss = ((a.x + a.y) + (a.z + a.w)) + ((b.x + b.y) + (b.z + b.w)) + ((c.x + c.y) + (c.z + c.w)) + ((d.x + d.y) + (d.z + d.w));
            ((float*)(F.ws + WS_RSTDE))[m] = 1.0f / sqrtf(ss * (1.0f / D) + RMS_EPS); }
        constexpr int NU_S = NBS, NU_T = NBP * NH * 6, NU_G = MP / 128, NU_g = NBS * NGRP / NWAVES, NU = NU_S + NU_T + NU_G + NU_g;
        const bool static_s = (F.G == 256) && (args.qlo == 0);
        if (static_s && (((int)blockIdx.x >> 3) & 1) == 0) samp_unit(F, ((int)blockIdx.x >> 4) * 8 + ((int)blockIdx.x & 7));
        const int ubase = args.qlo + (static_s ? NU_S : 0);
        unsigned tk = 0u; const bool t0 = (F.wave == 0) && (lane_id() == 0);
        if (t0) tk = __hip_atomic_fetch_add(F.ctl + CW_QHEAD, 1u, RLX_AGENT);
        for (;;) {
            __syncthreads();
            if (t0) F.MISC[16] = tk;
            __syncthreads();
            int u = (int)F.MISC[16] + ubase;
            if (u >= NU || u >= args.qhi) break;
            if (t0) tk = __hip_atomic_fetch_add(F.ctl + CW_QHEAD, 1u, RLX_AGENT);
            if (u < NU_S) { samp_unit(F, u); continue; } u -= NU_S;
            if (u < NU_T) { const int type = u >> 8, rem = u & 255, bh = rem & 127; tj_unit(F, bh >> 3, bh & 7, type, rem >> 7); continue; } u -= NU_T;
            if (u < NU_G) { gmlp_batch(F, u * 128); continue; } u -= NU_G;
            { const int task = u * NWAVES + F.wave; gmlp_sample_task(F, task >> 2, task & 3); }
        }
        if (BOTH(2)) GRID_BAR(2);
    }

    if (IN(3)) {
        { const int lane = lane_id(); for (int m = gw; m < MP; m += NGW) attn_finish_row(F, (size_t)m, lane); }
        if (BOTH(3)) GRID_BAR(3);
    }

    if (IN(4)) {
        for (int t = F.vcu; t < 256; t += F.G) small_tile<0>(F, t, (const bf16*)(F.ws + WS_MIX), (const bf16*)(F.ws + WS_WOUT));
        pg8::Gemm g{((bf16*)(F.ws + WS_MIX)), ((bf16*)(F.ws + WS_WOUT)), MP, D, D}; pg8::StaticOrder S; S.init(MP, D, F.G, (int)blockIdx.x);
        pg8::EpiOut E{((bf16*)(F.ws + WS_XB)), ((bf16*)(F.ws + WS_HB)), F.lds + pg8::STG_OFF};
        pg8::gemm_phase<pg8::EpiOut, pg8::StaticOrder, true, true>(F.lds + RING_OFF, g, S, E, F.wave);
        if (BOTH(4)) GRID_BAR(4);
    }

    if (IN(5)) {
        for (int t = F.vcu; t < 256; t += F.G) small_tile<1>(F, t, (const bf16*)(F.ws + WS_HB), (const bf16*)(F.ws + WS_WG));
        pg8::Gemm g{((bf16*)(F.ws + WS_HB)), ((bf16*)(F.ws + WS_WG)), MP, D, D}; pg8::StaticOrder S; S.init(MP, D, F.G, (int)blockIdx.x);
        pg8::EpiGate E{F.out + OUT_Y, ((bf16*)(F.ws + WS_HB)), ((bf16*)(F.ws + WS_ERAW)), ((float*)(F.ws + WS_RSTDE)), inp(17), F.lds + pg8::STG_OFF};
        pg8::gemm_phase<pg8::EpiGate, pg8::StaticOrder, true, true>(F.lds + RING_OFF, g, S, E, F.wave);
    }
#undef IN
#undef BOTH
#undef GRID_BAR
}

extern "C" void kernel_launch(void* const* d_in, const int* in_sizes, int n_in, void* d_out, int out_size, void* d_ws, size_t ws_size, hipStream_t stream) {
    static int grid = 0;
    if (grid == 0) {
        if (n_in != 19 || in_sizes[0] != MP * D || (size_t)out_size != OUT_END || ws_size < WS_END) { fprintf(stderr, "kernel_launch: unexpected shapes (n_in %d, in0 %d, out %d, ws %zu); nothing launched\n", n_in, n_in > 0 ? in_sizes[0] : -1, out_size, ws_size); grid = -1; return; }
        int dev = 0, cus = 0, per_cu = 0;
        if (hipGetDevice(&dev) != hipSuccess || hipDeviceGetAttribute(&cus, hipDeviceAttributeMultiprocessorCount, dev) != hipSuccess) { fprintf(stderr, "kernel_launch: device query failed\n"); grid = -1; return; }
        if (hipFuncSetAttribute((const void*)hymba_fwd, hipFuncAttributeMaxDynamicSharedMemorySize, LDS_BYTES) != hipSuccess) { fprintf(stderr, "kernel_launch: hipFuncSetAttribute failed\n"); grid = -1; return; }
        if (hipOccupancyMaxActiveBlocksPerMultiprocessor(&per_cu, (const void*)hymba_fwd, NWAVES * 64, LDS_BYTES) != hipSuccess || per_cu < 1)
            fprintf(stderr, "kernel_launch: note: occupancy query reports %d workgroups per CU\n", per_cu);
        (void)hipGetLastError();
        grid = cus;
    }
    if (grid < 0) return;
    if (hipMemsetAsync((char*)d_ws + WS_CTL, 0, CTL_ZERO_BYTES, stream) != hipSuccess) { fprintf(stderr, "kernel_launch: memset failed\n"); return; }
    Args a{};
    for (int i = 0; i < 19; ++i) a.in[i] = (const float*)d_in[i];
    a.out = (float*)d_out; a.ws = (unsigned char*)d_ws;
    static_assert(N_LAUNCHES == 1 || N_LAUNCHES == PER_PHASE, "MK_N_LAUNCHES is 1 or 6");
#ifndef PROBE_DUP
#define PROBE_DUP -1
#endif
#ifndef PROBE_QLO
#define PROBE_QLO 0
#endif
#ifndef PROBE_QHI
#define PROBE_QHI (1 << 30)
#endif
    for (int li = 0; li < N_LAUNCHES; ++li) {
        a.ph_lo = (N_LAUNCHES == PER_PHASE) ? li : 0; a.ph_hi = (N_LAUNCHES == PER_PHASE) ? li + 1 : PER_PHASE; a.qlo = 0; a.qhi = 1 << 30;
        const int reps = (N_LAUNCHES == PER_PHASE && PROBE_DUP == li && li < 4) ? 2 : 1;
        for (int rp = 0; rp < reps; ++rp) {
            if (rp == 1 && li == 2) { (void)hipMemsetAsync((char*)d_ws + WS_CTL + 4 * CW_QHEAD, 0, 16, stream); a.qlo = PROBE_QLO; a.qhi = PROBE_QHI; }
            hipLaunchKernelGGL(hymba_fwd, dim3(grid), dim3(NWAVES * 64), LDS_BYTES, stream, a);
            const hipError_t le = hipPeekAtLastError();
            if (le != hipSuccess) { fprintf(stderr, "kernel_launch: launch %d failed: %s\n", li, hipGetErrorName(le)); break; }
        }
    }
    if (N_LAUNCHES == PER_PHASE && PROBE_DUP == 4) for (int li = 4; li < 6; ++li) { a.ph_lo = li; a.ph_hi = li + 1; hipLaunchKernelGGL(hymba_fwd, dim3(grid), dim3(NWAVES * 64), LDS_BYTES, stream, a); }
}
```
